# Optimizing an MI355X kernel written in HIP

```python
import jax, jax.numpy as jnp
from jax import lax
import numpy as np

D_MODEL = 1024
BATCH = 32
SEQ = 2048
DEPTH = 2

GRID_W = 64
CTX_LEN = 256
HEAD_DIM = 64
AXIS_DIM = HEAD_DIM // 2
ROPE_THETA = 10000.0
A_HEADS = 6
A_KV = 2
A_GROUP = A_HEADS // A_KV
C_HEADS = 6
C_KV = 2
C_GROUP = C_HEADS // C_KV
POOL_GROUPS = 4
POOL_CH = 64
POOL_WIDTH = POOL_GROUPS * POOL_CH
POOL_WINDOWS = (2, 4, 8, 16)
WINDOW = 128
Q_BLOCK = 128
BAND = Q_BLOCK + 2 * WINDOW
D_FF = 4 * D_MODEL
N_BRANCH = 3
A_QW = A_HEADS * HEAD_DIM
A_KVW = A_KV * HEAD_DIM
C_QW = C_HEADS * HEAD_DIM
C_KVW = C_KV * HEAD_DIM
IN_SPLITS = (A_QW, A_KVW, A_KVW, C_QW, C_KVW, C_KVW, POOL_WIDTH, D_MODEL, D_MODEL, D_MODEL)
IN_WIDTH = A_QW + 2 * A_KVW + C_QW + 2 * C_KVW + POOL_WIDTH + N_BRANCH * D_MODEL
EPS = 1e-6
NEG = -1e30

kernel_name = "hybrid_prefix_gqa_pool_window_block"


def rmsnorm(x, g):
    xf = x.astype(jnp.float32)
    y = xf * lax.rsqrt(jnp.mean(xf * xf, axis=-1, keepdims=True) + EPS)
    return (y * g.astype(jnp.float32)).astype(x.dtype)


def modulate(x, g, shift, scale):
    return rmsnorm(x, g) * (1 + scale) + shift


def adaln(v, w, b):
    m = jax.nn.silu(v) @ w + b
    return jnp.split(m, 6, axis=-1)


def split_in(z):
    idx = []
    acc = 0
    for s in IN_SPLITS[:-1]:
        acc += s
        idx.append(acc)
    return jnp.split(z, idx, axis=-1)


def heads_q(t, n_kv, n_group):
    b, l, _ = t.shape
    return t.reshape(b, l, n_kv, n_group, HEAD_DIM)


def heads_kv(t, n_kv):
    b, l, _ = t.shape
    return t.reshape(b, l, n_kv, HEAD_DIM)


def rope_tables(n_tok):
    rows = n_tok // GRID_W
    r = jnp.repeat(jnp.arange(rows, dtype=jnp.float32), GRID_W)
    col = jnp.tile(jnp.arange(GRID_W, dtype=jnp.float32), rows)
    inv = 1.0 / (ROPE_THETA ** (jnp.arange(0, AXIS_DIM, 2, dtype=jnp.float32) / AXIS_DIM))
    ang = jnp.concatenate([r[:, None] * inv, col[:, None] * inv], axis=-1)
    return jnp.cos(ang), jnp.sin(ang)


def apply_rope(x, cos, sin):
    shp = x.shape
    xr = x.reshape(shp[:-1] + (shp[-1] // 2, 2))
    x0, x1 = xr[..., 0], xr[..., 1]
    bshape = (shp[1],) + (1,) * (x.ndim - 3) + (shp[-1] // 2,)
    cs = cos.reshape(bshape).astype(x.dtype)
    sn = sin.reshape(bshape).astype(x.dtype)
    return jnp.stack([x0 * cs - x1 * sn, x0 * sn + x1 * cs], axis=-1).reshape(shp)


def global_attn(q, k, v):
    b, s, hk, g, dh = q.shape
    nblk = s // Q_BLOCK
    qb = q.reshape(b, nblk, Q_BLOCK, hk, g, dh).transpose(1, 0, 2, 3, 4, 5)
    scale = dh ** -0.5

    def one_block(qi):
        sc = jnp.einsum('bqhgd,bkhd->bhgqk', qi, k).astype(jnp.float32) * scale
        p = jax.nn.softmax(sc, axis=-1).astype(v.dtype)
        return jnp.einsum('bhgqk,bkhd->bqhgd', p, v)

    o = lax.map(one_block, qb)
    return o.transpose(1, 0, 2, 3, 4, 5).reshape(b, s, hk * g * dh)


def window_attn(q, k, v, kc, vc, sink):
    b, s, hk, g, dh = q.shape
    nctx = kc.shape[1]
    nblk = s // Q_BLOCK
    scale = dh ** -0.5
    k_pad = jnp.pad(k, ((0, 0), (WINDOW, WINDOW), (0, 0), (0, 0)))
    v_pad = jnp.pad(v, ((0, 0), (WINDOW, WINDOW), (0, 0), (0, 0)))
    qb = q.reshape(b, nblk, Q_BLOCK, hk, g, dh).transpose(1, 0, 2, 3, 4, 5)
    sink_f = sink.astype(jnp.float32).reshape(1, hk, g, 1, 1)

    def one_block(args):
        qi, bi = args
        start = bi * Q_BLOCK
        kb = lax.dynamic_slice_in_dim(k_pad, start, BAND, axis=1)
        vb = lax.dynamic_slice_in_dim(v_pad, start, BAND, axis=1)
        qpos = start + jnp.arange(Q_BLOCK)
        kpos = start - WINDOW + jnp.arange(BAND)
        valid = (jnp.abs(qpos[:, None] - kpos[None, :]) <= WINDOW) & (kpos[None, :] >= 0) & (kpos[None, :] < s)
        s_loc = jnp.einsum('bqhgd,bkhd->bhgqk', qi, kb).astype(jnp.float32) * scale
        s_loc = jnp.where(valid, s_loc, NEG)
        s_ctx = jnp.einsum('bqhgd,bkhd->bhgqk', qi, kc).astype(jnp.float32) * scale
        s_sink = jnp.broadcast_to(sink_f, s_ctx.shape[:-1] + (1,))
        p = jax.nn.softmax(jnp.concatenate([s_ctx, s_loc, s_sink], axis=-1), axis=-1).astype(v.dtype)
        o = jnp.einsum('bhgqk,bkhd->bqhgd', p[..., :nctx], vc)
        return o + jnp.einsum('bhgqk,bkhd->bqhgd', p[..., nctx:nctx + BAND], vb)

    o = lax.map(one_block, (qb, jnp.arange(nblk)))
    return o.transpose(1, 0, 2, 3, 4, 5).reshape(b, s, hk * g * dh)


def ctx_attn(q, k, v, sink):
    b, n, hk, g, dh = q.shape
    sc = jnp.einsum('bqhgd,bkhd->bhgqk', q, k).astype(jnp.float32) * (dh ** -0.5)
    if sink is not None:
        sk = jnp.broadcast_to(sink.astype(jnp.float32).reshape(1, hk, g, 1, 1), sc.shape[:-1] + (1,))
        p = jax.nn.softmax(jnp.concatenate([sc, sk], axis=-1), axis=-1)[..., :-1]
    else:
        p = jax.nn.softmax(sc, axis=-1)
    o = jnp.einsum('bhgqk,bkhd->bqhgd', p.astype(v.dtype), v)
    return o.reshape(b, n, hk * g * dh)


def pool_mix(u, w_pool, pool_scale):
    b, n, _ = u.shape
    uf = u.astype(jnp.float32).reshape(b, n, POOL_GROUPS, POOL_CH)
    cs = jnp.concatenate([jnp.zeros((b, 1, POOL_GROUPS, POOL_CH), jnp.float32), jnp.cumsum(uf, axis=1)], axis=1)
    t = jnp.arange(n)
    outs = []
    for gi, w in enumerate(POOL_WINDOWS):
        lo = jnp.clip(t - w // 2, 0, n)
        hi = jnp.clip(t + w - w // 2, 0, n)
        tot = cs[:, hi, gi] - cs[:, lo, gi]
        cnt = (hi - lo).astype(jnp.float32)
        outs.append(tot / cnt[None, :, None] - uf[:, :, gi])
    pooled = jnp.stack(outs, axis=2).astype(u.dtype)
    mixed = jnp.einsum('blgc,gcd->blgd', pooled, w_pool).reshape(b, n, POOL_WIDTH)
    return mixed * pool_scale


def project(h, w_in, qn_a, kn_a, qn_c, kn_c):
    qa, ka, va, qc, kc, vc, u, ga, gb, gc = split_in(h @ w_in)
    qa = rmsnorm(heads_q(qa, A_KV, A_GROUP), qn_a)
    ka = rmsnorm(heads_kv(ka, A_KV), kn_a)
    va = heads_kv(va, A_KV)
    qc = rmsnorm(heads_q(qc, C_KV, C_GROUP), qn_c)
    kc = rmsnorm(heads_kv(kc, C_KV), kn_c)
    vc = heads_kv(vc, C_KV)
    return qa, ka, va, qc, kc, vc, u, ga, gb, gc


def merge(oa, ob, oc, ga, gb, gc, w_br_a, w_br_b, w_br_c, w_out):
    y = (jax.nn.sigmoid(ga) * (oa @ w_br_a)
         + jax.nn.sigmoid(gb) * (ob @ w_br_b)
         + jax.nn.sigmoid(gc) * (oc @ w_br_c))
    return y @ w_out


def mlp(h, w1, w2):
    return jnp.square(jax.nn.relu(h @ w1)) @ w2


def setup_inputs(seed: int = 0) -> dict:
    key = jax.random.key(seed)
    ks = jax.random.split(key, 24)
    f32 = jnp.float32
    nrm = lambda k, shp, s: jax.random.normal(k, shp, f32) * s
    return {
        "x": nrm(ks[0], (BATCH, SEQ, D_MODEL), 1.0),
        "c": nrm(ks[1], (BATCH, D_MODEL), 1.0),
        "ctx": nrm(ks[2], (BATCH, CTX_LEN, D_MODEL), 1.0),
        "c_ctx": nrm(ks[3], (D_MODEL,), 1.0),
        "w_ada": nrm(ks[4], (DEPTH, D_MODEL, 6 * D_MODEL), 0.5 * D_MODEL ** -0.5),
        "b_ada": nrm(ks[5], (DEPTH, 6 * D_MODEL), 0.02),
        "norm1": 1.0 + nrm(ks[6], (DEPTH, D_MODEL), 0.1),
        "norm2": 1.0 + nrm(ks[7], (DEPTH, D_MODEL), 0.1),
        "w_in": nrm(ks[8], (DEPTH, D_MODEL, IN_WIDTH), D_MODEL ** -0.5),
        "q_norm_a": 1.0 + nrm(ks[9], (DEPTH, HEAD_DIM), 0.1),
        "k_norm_a": 1.0 + nrm(ks[10], (DEPTH, HEAD_DIM), 0.1),
        "q_norm_c": 1.0 + nrm(ks[11], (DEPTH, HEAD_DIM), 0.1),
        "k_norm_c": 1.0 + nrm(ks[12], (DEPTH, HEAD_DIM), 0.1),
        "sink_c": nrm(ks[13], (DEPTH, C_HEADS), 0.5),
        "w_pool": nrm(ks[14], (DEPTH, POOL_GROUPS, POOL_CH, POOL_CH), POOL_CH ** -0.5),
        "pool_scale": 1.0 + nrm(ks[15], (DEPTH, POOL_WIDTH), 0.1),
        "w_br_a": nrm(ks[16], (DEPTH, A_QW, D_MODEL), A_QW ** -0.5),
        "w_br_b": nrm(ks[17], (DEPTH, POOL_WIDTH, D_MODEL), POOL_WIDTH ** -0.5),
        "w_br_c": nrm(ks[18], (DEPTH, C_QW, D_MODEL), C_QW ** -0.5),
        "w_out": nrm(ks[19], (DEPTH, D_MODEL, D_MODEL), D_MODEL ** -0.5),
        "w_mlp1": nrm(ks[20], (DEPTH, D_MODEL, D_FF), D_MODEL ** -0.5),
        "w_mlp2": nrm(ks[21], (DEPTH, D_FF, D_MODEL), D_FF ** -0.5),
    }


def reference(x, c, ctx, c_ctx, w_ada, b_ada, norm1, norm2, w_in, q_norm_a, k_norm_a, q_norm_c, k_norm_c,
              sink_c, w_pool, pool_scale, w_br_a, w_br_b, w_br_c, w_out, w_mlp1, w_mlp2):
    n_tok = x.shape[1]
    cos, sin = rope_tables(n_tok)
    xc = ctx
    for l in range(DEPTH):
        last = l == DEPTH - 1
        sh1, sc1, g1, sh2, sc2, g2 = [m[:, None, :] for m in adaln(c, w_ada[l], b_ada[l])]
        csh1, csc1, cg1, csh2, csc2, cg2 = adaln(c_ctx, w_ada[l], b_ada[l])

        hc = modulate(xc, norm1[l], csh1, csc1)
        cqa, cka, cva, cqc, ckc, cvc, cu, cga, cgb, cgc = project(
            hc, w_in[l], q_norm_a[l], k_norm_a[l], q_norm_c[l], k_norm_c[l])

        h = modulate(x, norm1[l], sh1, sc1)
        qa, ka, va, qc, kc, vc, u, ga, gb, gc = project(
            h, w_in[l], q_norm_a[l], k_norm_a[l], q_norm_c[l], k_norm_c[l])
        qa, ka = apply_rope(qa, cos, sin), apply_rope(ka, cos, sin)
        qc, kc = apply_rope(qc, cos, sin), apply_rope(kc, cos, sin)

        oa = global_attn(qa, jnp.concatenate([cka, ka], axis=1), jnp.concatenate([cva, va], axis=1))
        ob = pool_mix(u, w_pool[l], pool_scale[l])
        oc = window_attn(qc, kc, vc, ckc, cvc, sink_c[l])
        x = x + g1 * merge(oa, ob, oc, ga, gb, gc, w_br_a[l], w_br_b[l], w_br_c[l], w_out[l])
        x = x + g2 * mlp(modulate(x, norm2[l], sh2, sc2), w_mlp1[l], w_mlp2[l])

        if not last:
            coa = ctx_attn(cqa, cka, cva, None)
            cob = pool_mix(cu, w_pool[l], pool_scale[l])
            coc = ctx_attn(cqc, ckc, cvc, sink_c[l])
            xc = xc + cg1 * merge(coa, cob, coc, cga, cgb, cgc, w_br_a[l], w_br_b[l], w_br_c[l], w_out[l])
            xc = xc + cg2 * mlp(modulate(xc, norm2[l], csh2, csc2), w_mlp1[l], w_mlp2[l])
    return x
```

```cpp
#include <hip/hip_runtime.h>
#include <hip/hip_cooperative_groups.h>
#include <cstdio>
namespace cg = cooperative_groups;

#define LAS __attribute__((address_space(3)))
typedef unsigned short bf16;
typedef short bf16x8 __attribute__((ext_vector_type(8)));
typedef float f32x4 __attribute__((ext_vector_type(4)));
typedef float f32x16 __attribute__((ext_vector_type(16)));
typedef unsigned u32x4 __attribute__((ext_vector_type(4)));
typedef unsigned u32x2 __attribute__((ext_vector_type(2)));

#ifndef ONE_LAUNCH
#define ONE_LAUNCH 1
#endif

constexpr int D = 1024, NB = 32, SEQ = 2048, CTXL = 256;
constexpr int TL = NB * SEQ, TC = NB * CTXL, TT = TL + TC;
constexpr int NKEY = CTXL + SEQ;
constexpr int ZQW = 1536, GWD = 3072, FF = 4096, INW = 4608;
constexpr int ZC_KA = 0, ZC_VA = 128, ZC_KC = 256, ZC_VC = 384, ZC_QA = 512, ZC_QC = 896, ZC_U = 1280;
constexpr float EPS = 1e-6f;
constexpr float LOG2E = 1.4426950408889634f;
constexpr float QSCALE = 0.125f * LOG2E;
constexpr int NTHR = 512, NWAVES = 8;
constexpr int LDS_BYTES = 147456;

constexpr size_t MiB = 1u << 20;
constexpr size_t WS_MOD = 1 * MiB;
constexpr size_t WS_ROPE = 3 * MiB;
constexpr size_t WS_W = 4 * MiB;
constexpr size_t WL_IN = 0, WL_W1 = 9 * MiB, WL_W2 = 17 * MiB, WL_WO = 25 * MiB, WL_BR = 27 * MiB, WL_SIZE = 29 * MiB;
constexpr size_t WS_XC = 62 * MiB;
constexpr size_t WS_B1 = 94 * MiB;
constexpr size_t WS_ZQ = 238 * MiB;
constexpr size_t WS_G = 454 * MiB;
constexpr size_t WS_K = 886 * MiB;
constexpr size_t WS_VT = 922 * MiB;
constexpr size_t WS_SH = 958 * MiB;
constexpr size_t WS_BIAS1 = 960 * MiB;
constexpr size_t WS_BIAS2 = 961 * MiB;
constexpr size_t WS_AV = 963 * MiB;
constexpr size_t WS_RSS = 964 * MiB;
constexpr size_t WS_END = 965 * MiB;

__device__ __forceinline__ unsigned cvt_pk_bf16(float lo, float hi) { unsigned r; asm volatile("v_cvt_pk_bf16_f32 %0, %1, %2" : "=v"(r) : "v"(lo), "v"(hi)); return r; }
__device__ __forceinline__ float bf_lo(unsigned u) { return __uint_as_float(u << 16); }
__device__ __forceinline__ float bf_hi(unsigned u) { return __uint_as_float(u & 0xffff0000u); }
__device__ __forceinline__ float wave_sum(float v) {
#pragma unroll
    for (int o = 1; o < 64; o <<= 1) v += __shfl_xor(v, o);
    return v;
}
__device__ __forceinline__ float fast_exp2(float x) { return __builtin_amdgcn_exp2f(x); }
__device__ __forceinline__ float sigmoidf_(float x) { return __builtin_amdgcn_rcpf(1.0f + fast_exp2(-x * LOG2E)); }

__device__ __forceinline__ size_t blk_off(int row, int col, int K) { return ((size_t)(row >> 8) * (size_t)(K >> 6) + (size_t)(col >> 6)) * 16384 + (size_t)(row & 255) * 64 + (size_t)(col & 63); }

namespace pg8 {
constexpr int BM = 256, BK = 64, HALF = 128, HTB = HALF * BK * 2, STAGE_BYTES = 8 * HTB;
__device__ __forceinline__ int lds_byte(int r, int c) { const int st = (r >> 4) * 2 + (c >> 5), rr = r & 15, cc = c & 31, ob = rr * 64 + cc * 2; return st * 1024 + (ob ^ (((ob >> 9) & 1) << 5)); }
__device__ __forceinline__ void stage_rc(int b, int& R, int& C) { const int st = b / 1024, sb = b % 1024, swz = sb ^ (((sb >> 9) & 1) << 5); R = (st >> 1) * 16 + swz / 64; C = (st & 1) * 32 + (swz % 64) / 2; }
__device__ __forceinline__ int perm32(int rho) { const int n = rho >> 4, i = rho & 15; return 8 * (i >> 2) + 4 * n + (i & 3); }

struct Unit { int pm, pn, k0, nt, tag; };

struct Order {
    int nM0, nN0, nM1, nN1, n0, ntot, G, c, nseg, ntfull;
    __device__ __forceinline__ void init(int nM0_, int nN0_, int nM1_, int nN1_, int nseg_, int ntfull_, int G_, int c_) {
        nM0 = nM0_; nN0 = nN0_; nM1 = nM1_; nN1 = nN1_; n0 = nM0 * nN0; ntot = n0 + nM1 * nN1; nseg = nseg_; ntfull = ntfull_; G = G_; c = c_; }
    static __device__ __forceinline__ void map(int L, int nM, int nN, int& pm, int& pn) {
        const int nwg = nM * nN; int wgid = L;
        { const int q = nwg / 8, r = nwg % 8, xcd = wgid % 8, off = wgid / 8; wgid = (xcd < r ? xcd * (q + 1) : r * (q + 1) + (xcd - r) * q) + off; }
        const int nig = 8 * nN, gid = wgid / nig, fm = gid * 8, gsz = (nM - fm) < 8 ? (nM - fm) : 8;
        pm = fm + ((wgid % nig) % gsz); pn = (wgid % nig) / gsz;
    }
    __device__ __forceinline__ bool next(int i, Unit& u) const {
        int ti = i, sg = 0;
        if (nseg == 3) { ti = i / 3; sg = i - 3 * ti; }
        const int L = ti * G + c; if (L >= ntot) return false;
        int pm, pn;
        if (L < n0) map(L, nM0, nN0, pm, pn); else { map(L - n0, nM1, nN1, pm, pn); pm += nM0; }
        u.pm = pm; u.pn = pn; u.tag = sg;
        if (nseg == 3) { u.k0 = sg == 0 ? 0 : (sg == 1 ? 384 : 640); u.nt = sg == 1 ? 4 : 6; } else { u.k0 = 0; u.nt = ntfull; }
        return true;
    }
};

template <class Epi>
__device__ __forceinline__ void gemm_phase(LAS unsigned char* lds, const bf16* A, int lda, const bf16* Bt, int ldb, const Order& S, const Epi& E) {
    int tid_ = threadIdx.x; asm volatile("" : "+v"(tid_));
    const int tid = tid_, wid = __builtin_amdgcn_readfirstlane(tid >> 6), lane = tid & 63, wr = wid >> 2, wc = wid & 3, fr = lane & 15, fq = lane >> 4;
    unsigned voffA[2], voffB[2];
#pragma unroll
    for (int i = 0; i < 2; ++i) { int R, C; stage_rc(tid * 16 + i * 8192, R, C); const int Rb = Epi::PERM ? ((R & ~31) + perm32(R & 31)) : R;
        voffA[i] = (unsigned)(R * 64 + C) * 2u; voffB[i] = (unsigned)(Rb * ldb + C) * 2u; }
    const size_t kstep = (size_t)(BK * 2), kstepA = 32768;
    const size_t hstepA = 16384, hstepB = (size_t)HALF * ldb * 2;
    const unsigned ldsw = (unsigned)wid * 1024u;
    const int aoff = lds_byte(wr * 64 + fr, fq * 8), boff = lds_byte(wc * 32 + fr, fq * 8);
#define PG8_SA(b, h) (((b) * 2 + (h)) * HTB)
#define PG8_SB(b, h) ((4 + (b) * 2 + (h)) * HTB)
#define PG8_STAGE(bufoff, gbase, voff) do { _Pragma("unroll") for (int _i = 0; _i < 2; ++_i) \
        __builtin_amdgcn_global_load_lds((const unsigned*)((const char*)(gbase) + (voff)[_i]), (LAS unsigned*)(lds + (bufoff) + ldsw + _i * 8192), 16, 0, 0); } while (0)
#define PG8_LDA(dst, b, h) do { _Pragma("unroll") for (int m = 0; m < 4; ++m) _Pragma("unroll") for (int k = 0; k < 2; ++k) dst[m][k] = *(const LAS bf16x8*)(lds + PG8_SA(b, h) + aoff + m * 2048 + k * 1024); } while (0)
#define PG8_LDB(dst, b, h) do { _Pragma("unroll") for (int n = 0; n < 2; ++n) _Pragma("unroll") for (int k = 0; k < 2; ++k) dst[n][k] = *(const LAS bf16x8*)(lds + PG8_SB(b, h) + boff + n * 2048 + k * 1024); } while (0)
#define PG8_MMA(ai, bj, At, Bt_) do { __builtin_amdgcn_s_setprio(1); _Pragma("unroll") for (int m = 0; m < 4; ++m) _Pragma("unroll") for (int n = 0; n < 2; ++n) _Pragma("unroll") for (int k = 0; k < 2; ++k) \
        acc[ai][bj][m][n] = __builtin_amdgcn_mfma_f32_16x16x32_bf16(Bt_[n][k], At[m][k], acc[ai][bj][m][n], 0, 0, 0); __builtin_amdgcn_s_setprio(0); } while (0)
#define PG8_WAIT_V(n) asm volatile("s_waitcnt vmcnt(" #n ")" ::: "memory")
#define PG8_WAIT_L(n) asm volatile("s_waitcnt lgkmcnt(" #n ")" ::: "memory")
#define PG8_BAR __builtin_amdgcn_s_barrier()
#define PG8_SCHED __builtin_amdgcn_sched_barrier(0)
    Unit cur, nxt; int ui = 0;
    if (!S.next(0, cur)) return;
    f32x4 acc[2][2][4][2];
#pragma unroll
    for (int a = 0; a < 2; ++a)
#pragma unroll
        for (int b = 0; b < 2; ++b)
#pragma unroll
            for (int m = 0; m < 4; ++m)
#pragma unroll
                for (int n = 0; n < 2; ++n) acc[a][b][m][n] = (f32x4){0.f, 0.f, 0.f, 0.f};
    bf16x8 At[4][2], B0[2][2], B1[2][2];
    const char* cA = (const char*)A + blk_off(cur.pm * 256, cur.k0, lda) * 2; const char* cB = (const char*)Bt + ((size_t)cur.pn * 256 * ldb + cur.k0) * 2;
    PG8_STAGE(PG8_SB(0, 0), cB, voffB); PG8_STAGE(PG8_SB(0, 1), cB + hstepB, voffB); PG8_STAGE(PG8_SA(0, 0), cA, voffA); PG8_STAGE(PG8_SA(0, 1), cA + hstepA, voffA);
    if (wr == 1) PG8_BAR;
    PG8_WAIT_V(2); PG8_BAR;
    PG8_STAGE(PG8_SB(1, 0), cB + kstep, voffB); PG8_STAGE(PG8_SA(1, 0), cA + kstepA, voffA); PG8_STAGE(PG8_SB(1, 1), cB + hstepB + kstep, voffB);
    PG8_WAIT_V(6); PG8_BAR;
    for (;;) {
        const bool has_next = S.next(ui + 1, nxt);
        const char* nA = has_next ? (const char*)A + blk_off(nxt.pm * 256, nxt.k0, lda) * 2 : cA; const char* nB = has_next ? (const char*)Bt + ((size_t)nxt.pn * 256 * ldb + nxt.k0) * 2 : cB;
        const int nt = cur.nt;
        for (int t = 0; t < nt; t += 2) {
            const bool last = (t == nt - 2);
            if constexpr (Epi::HOOK) { if (t == 6 || t == 10) E.mid(acc, cur, t == 6 ? 0 : 1, wr, wc, fr, fq); }
            const char* a1 = cA + (size_t)(t + 1) * kstepA;
            const char* a2 = last ? nA : cA + (size_t)(t + 2) * kstepA; const char* b2 = last ? nB : cB + (size_t)(t + 2) * kstep;
            const char* a3 = a2 + kstepA; const char* b3 = b2 + kstep;
            PG8_LDB(B0, 0, 0); PG8_LDB(B1, 0, 1); PG8_SCHED; PG8_LDA(At, 0, 0); PG8_STAGE(PG8_SA(1, 1), a1 + hstepA, voffA);
            PG8_WAIT_V(8); PG8_WAIT_L(0); PG8_BAR; PG8_MMA(0, 0, At, B0); PG8_MMA(0, 1, At, B1); PG8_BAR; PG8_SCHED;
            PG8_LDA(At, 0, 1); PG8_STAGE(PG8_SB(0, 0), b2, voffB); PG8_STAGE(PG8_SB(0, 1), b2 + hstepB, voffB); PG8_STAGE(PG8_SA(0, 0), a2, voffA);
            PG8_WAIT_V(8); PG8_WAIT_L(0); PG8_BAR; PG8_MMA(1, 0, At, B0); PG8_MMA(1, 1, At, B1); PG8_BAR; PG8_SCHED;
            PG8_LDB(B0, 1, 0); PG8_LDB(B1, 1, 1); PG8_SCHED; PG8_LDA(At, 1, 0); PG8_STAGE(PG8_SA(0, 1), a2 + hstepA, voffA);
            PG8_WAIT_V(8); PG8_WAIT_L(0); PG8_BAR; PG8_MMA(0, 0, At, B0); PG8_MMA(0, 1, At, B1); PG8_BAR; PG8_SCHED;
            PG8_LDA(At, 1, 1); PG8_STAGE(PG8_SB(1, 0), b3, voffB); PG8_STAGE(PG8_SB(1, 1), b3 + hstepB, voffB); PG8_STAGE(PG8_SA(1, 0), a3, voffA);
            PG8_WAIT_V(8); PG8_WAIT_L(0); PG8_BAR; PG8_MMA(1, 0, At, B0); PG8_MMA(1, 1, At, B1); PG8_BAR; PG8_SCHED;
        }
        if (wr == 0) PG8_BAR;
        E(acc, cur, wr, wc, fr, fq);
        if (!has_next) break;
#pragma unroll
        for (int a = 0; a < 2; ++a)
#pragma unroll
            for (int b = 0; b < 2; ++b)
#pragma unroll
                for (int m = 0; m < 4; ++m)
#pragma unroll
                    for (int n = 0; n < 2; ++n) acc[a][b][m][n] = (f32x4){0.f, 0.f, 0.f, 0.f};
        cur = nxt; cA = nA; cB = nB; ++ui;
        if (wr == 1) PG8_BAR;
    }
    PG8_WAIT_V(0);
    PG8_BAR;
#undef PG8_SA
#undef PG8_SB
#undef PG8_STAGE
#undef PG8_LDA
#undef PG8_LDB
#undef PG8_MMA
#undef PG8_WAIT_V
#undef PG8_WAIT_L
#undef PG8_BAR
#undef PG8_SCHED
}

struct EpiInProj {
    static constexpr bool PERM = true, HOOK = false;
    bf16* ZQ; bf16* G; const float* rss; const float* bias; int fused;
    __device__ __forceinline__ void operator()(const f32x4 (&acc)[2][2][4][2], const Unit& u, int wr, int wc, int fr, int fq) const {
        const int row0 = u.pm * 256 + wr * 64 + fr;
        const bool gate = u.pn >= 6;
        bf16* base = gate ? G : ZQ; const int ld = gate ? GWD : ZQW; const int col0 = (gate ? (u.pn - 6) * 256 : u.pn * 256) + wc * 32 + 8 * fq;
        f32x4 bv[2][2];
#pragma unroll
        for (int bj = 0; bj < 2; ++bj) { bv[bj][0] = (f32x4){0.f, 0.f, 0.f, 0.f}; bv[bj][1] = bv[bj][0]; }
        if (fused) { const int r = u.pm >= 256 ? 32 : (u.pm >> 3); const float* bp = bias + (size_t)r * INW + u.pn * 256 + wc * 32 + 8 * fq;
#pragma unroll
            for (int bj = 0; bj < 2; ++bj) { bv[bj][0] = *(const f32x4*)(bp + bj * 128); bv[bj][1] = *(const f32x4*)(bp + bj * 128 + 4); } }
        const float gsc = gate ? -LOG2E : 1.0f;
#pragma unroll
        for (int bj = 0; bj < 2; ++bj) { bv[bj][0] *= gsc; bv[bj][1] *= gsc; }
        float rsv[8];
#pragma unroll
        for (int q = 0; q < 8; ++q) rsv[q] = 1.0f;
        if (fused) {
#pragma unroll
            for (int q = 0; q < 8; ++q) rsv[q] = rss[row0 + (q >> 2) * 128 + (q & 3) * 16];
#pragma unroll
            for (int q = 0; q < 8; ++q) rsv[q] = rsqrtf(rsv[q] * (1.0f / 1024.0f) + EPS); }
#pragma unroll
        for (int ai = 0; ai < 2; ++ai)
#pragma unroll
            for (int m = 0; m < 4; ++m) { bf16* rowp = base + (size_t)(row0 + ai * 128 + m * 16) * ld + col0;
                const float rs = rsv[ai * 4 + m];
#pragma unroll
                for (int bj = 0; bj < 2; ++bj) { f32x4 v0 = acc[ai][bj][m][0] * (rs * gsc) + bv[bj][0], v1 = acc[ai][bj][m][1] * (rs * gsc) + bv[bj][1];
                    if (gate) {
#pragma unroll
                        for (int j = 0; j < 4; ++j) { v0[j] = __builtin_amdgcn_rcpf(1.0f + fast_exp2(__builtin_amdgcn_fmed3f(v0[j], -99.f, 99.f))); v1[j] = __builtin_amdgcn_rcpf(1.0f + fast_exp2(__builtin_amdgcn_fmed3f(v1[j], -99.f, 99.f)));     } }
                    u32x4 w; w.x = cvt_pk_bf16(v0[0], v0[1]); w.y = cvt_pk_bf16(v0[2], v0[3]); w.z = cvt_pk_bf16(v1[0], v1[1]); w.w = cvt_pk_bf16(v1[2], v1[3]);
                    *(u32x4*)(rowp + bj * 128) = w; } }
    }
};
struct EpiMerge {
    static constexpr bool PERM = true, HOOK = true;
    const bf16* G; bf16* Y;
    __device__ __forceinline__ void mid(f32x4 (&acc)[2][2][4][2], const Unit& u, int which, int wr, int wc, int fr, int fq) const {
        const int row0 = u.pm * 256 + wr * 64 + fr, col0 = u.pn * 256 + wc * 32 + 8 * fq;
        const bf16* gp = G + (size_t)row0 * GWD + which * 1024 + col0;
#pragma unroll
        for (int ai = 0; ai < 2; ++ai) {
            asm volatile("" : "+v"(gp));
            u32x4 gnv[4][2], gdv[4][2];
#pragma unroll
            for (int m = 0; m < 4; ++m)
#pragma unroll
                for (int bj = 0; bj < 2; ++bj) { gnv[m][bj] = *(const u32x4*)(gp + (size_t)m * 16 * GWD + bj * 128); gdv[m][bj] = *(const u32x4*)(gp + (size_t)m * 16 * GWD + 1024 + bj * 128); }
            __builtin_amdgcn_sched_barrier(0);
#pragma unroll
            for (int m = 0; m < 4; ++m)
#pragma unroll
                for (int bj = 0; bj < 2; ++bj) { const u32x4 gn = gnv[m][bj], gd = gdv[m][bj];
                    f32x4& v0 = acc[ai][bj][m][0]; f32x4& v1 = acc[ai][bj][m][1];
                    v0[0] *= bf_lo(gn.x) * __builtin_amdgcn_rcpf(bf_lo(gd.x)); v0[1] *= bf_hi(gn.x) * __builtin_amdgcn_rcpf(bf_hi(gd.x));
                    v0[2] *= bf_lo(gn.y) * __builtin_amdgcn_rcpf(bf_lo(gd.y)); v0[3] *= bf_hi(gn.y) * __builtin_amdgcn_rcpf(bf_hi(gd.y));
                    v1[0] *= bf_lo(gn.z) * __builtin_amdgcn_rcpf(bf_lo(gd.z)); v1[1] *= bf_hi(gn.z) * __builtin_amdgcn_rcpf(bf_hi(gd.z));
                    v1[2] *= bf_lo(gn.w) * __builtin_amdgcn_rcpf(bf_lo(gd.w)); v1[3] *= bf_hi(gn.w) * __builtin_amdgcn_rcpf(bf_hi(gd.w)); }
            asm volatile("" ::: "memory");
            gp += (size_t)128 * GWD;
        }
    }
    __device__ __forceinline__ void operator()(const f32x4 (&acc)[2][2][4][2], const Unit& u, int wr, int wc, int fr, int fq) const {
        const int row0 = u.pm * 256 + wr * 64 + fr, col0 = u.pn * 256 + wc * 32 + 8 * fq;
#pragma unroll
        for (int ai = 0; ai < 2; ++ai) {
            u32x4 gr[4][2];
#pragma unroll
            for (int m = 0; m < 4; ++m)
#pragma unroll
                for (int bj = 0; bj < 2; ++bj) gr[m][bj] = *(const u32x4*)(G + (size_t)(row0 + ai * 128 + m * 16) * GWD + 2 * 1024 + col0 + bj * 128);
#pragma unroll
            for (int m = 0; m < 4; ++m) { const size_t row = (size_t)(row0 + ai * 128 + m * 16);
#pragma unroll
                for (int bj = 0; bj < 2; ++bj) { const int col = col0 + bj * 128;
                    const u32x4 g = gr[m][bj];
                    const f32x4 v0 = acc[ai][bj][m][0], v1 = acc[ai][bj][m][1];
                    u32x4 w;
                    w.x = cvt_pk_bf16(bf_lo(g.x) * v0[0], bf_hi(g.x) * v0[1]);
                    w.y = cvt_pk_bf16(bf_lo(g.y) * v0[2], bf_hi(g.y) * v0[3]);
                    w.z = cvt_pk_bf16(bf_lo(g.z) * v1[0], bf_hi(g.z) * v1[1]);
                    w.w = cvt_pk_bf16(bf_lo(g.w) * v1[2], bf_hi(g.w) * v1[3]);
                    *(u32x4*)(Y + blk_off((int)row, col, 1024)) = w; } }
            asm volatile("" ::: "memory"); }
    }
};
struct EpiResid {
    static constexpr bool PERM = false, HOOK = false;
    const float* src_lat; const float* src_ctx; float* dst_lat; float* dst_ctx; const float* modl; int gidx;
    bf16* XA; const float* av; float* rowss;
    __device__ __forceinline__ void operator()(const f32x4 (&acc)[2][2][4][2], const Unit& u, int wr, int wc, int fr, int fq) const {
        const bool isctx = u.pm >= 256; const int r = isctx ? 32 : (u.pm >> 3);
        const int row0 = (isctx ? (u.pm - 256) * 256 : u.pm * 256) + wr * 64 + fr, col0 = u.pn * 256 + wc * 32 + 4 * fq;
        const int grow0 = u.pm * 256 + wr * 64 + fr;
        const float* src = isctx ? src_ctx : src_lat; float* dst = isctx ? dst_ctx : dst_lat;
        const bool fuse = XA != nullptr;
        f32x4 gv[2][2], avv[2][2];
#pragma unroll
        for (int bj = 0; bj < 2; ++bj)
#pragma unroll
            for (int n = 0; n < 2; ++n) { gv[bj][n] = *(const f32x4*)(modl + (size_t)r * 6144 + gidx * 1024 + col0 + bj * 128 + n * 16);
                avv[bj][n] = (f32x4){0.f, 0.f, 0.f, 0.f}; if (fuse) avv[bj][n] = *(const f32x4*)(av + (size_t)r * 1024 + col0 + bj * 128 + n * 16); }
#pragma unroll
        for (int ai = 0; ai < 2; ++ai)
#pragma unroll
        for (int mh = 0; mh < 2; ++mh) {
            f32x4 xr[2][2][2];
#pragma unroll
            for (int mm = 0; mm < 2; ++mm)
#pragma unroll
                for (int bj = 0; bj < 2; ++bj)
#pragma unroll
                    for (int n = 0; n < 2; ++n) xr[mm][bj][n] = *(const f32x4*)(src + (size_t)(row0 + ai * 128 + (2 * mh + mm) * 16) * 1024 + col0 + bj * 128 + n * 16);
#pragma unroll
            for (int mm = 0; mm < 2; ++mm) { const int m = 2 * mh + mm; const size_t off = (size_t)(row0 + ai * 128 + m * 16) * 1024 + col0; const int grow = grow0 + ai * 128 + m * 16;
                float ss = 0.f;
#pragma unroll
                for (int bj = 0; bj < 2; ++bj)
#pragma unroll
                    for (int n = 0; n < 2; ++n) { const f32x4 y = xr[mm][bj][n] + gv[bj][n] * acc[ai][bj][m][n];
                        *(f32x4*)(dst + off + bj * 128 + n * 16) = y;
                        if (fuse) { ss += (y.x * y.x + y.y * y.y) + (y.z * y.z + y.w * y.w); const f32x4 h = y * avv[bj][n];
                            u32x2 w; w.x = cvt_pk_bf16(h.x, h.y); w.y = cvt_pk_bf16(h.z, h.w); *(u32x2*)(XA + blk_off(grow, col0 + bj * 128 + n * 16, 1024)) = w; } }
                if (fuse) { ss += __shfl_xor(ss, 16); ss += __shfl_xor(ss, 32); if (fq == 0) atomicAdd(rowss + grow, ss); } }
            asm volatile("" ::: "memory");
        }
    }
};
struct EpiMlp1 {
    static constexpr bool PERM = true, HOOK = false;
    bf16* A1; const float* rss; const float* bias;
    __device__ __forceinline__ void operator()(const f32x4 (&acc)[2][2][4][2], const Unit& u, int wr, int wc, int fr, int fq) const {
        const int row0 = u.pm * 256 + wr * 64 + fr, col0 = u.pn * 256 + wc * 32 + 8 * fq;
        const int r = u.pm >= 256 ? 32 : (u.pm >> 3);
        f32x4 bv[2][2];
#pragma unroll
        for (int bj = 0; bj < 2; ++bj) { bv[bj][0] = *(const f32x4*)(bias + (size_t)r * FF + col0 + bj * 128); bv[bj][1] = *(const f32x4*)(bias + (size_t)r * FF + col0 + bj * 128 + 4); }
        float rsv[8];
#pragma unroll
        for (int q = 0; q < 8; ++q) rsv[q] = rss[row0 + (q >> 2) * 128 + (q & 3) * 16];
#pragma unroll
        for (int q = 0; q < 8; ++q) rsv[q] = rsqrtf(rsv[q] * (1.0f / 1024.0f) + EPS);
#pragma unroll
        for (int ai = 0; ai < 2; ++ai)
#pragma unroll
            for (int m = 0; m < 4; ++m) { bf16* rowp = A1 + blk_off(row0 + ai * 128 + m * 16, col0, FF);
                const float rs = rsv[ai * 4 + m];
#pragma unroll
                for (int bj = 0; bj < 2; ++bj) { f32x4 v0 = acc[ai][bj][m][0] * rs + bv[bj][0], v1 = acc[ai][bj][m][1] * rs + bv[bj][1];
#pragma unroll
                    for (int j = 0; j < 4; ++j) { const float a = fmaxf(v0[j], 0.f), b = fmaxf(v1[j], 0.f); v0[j] = a * a; v1[j] = b * b; }
                    u32x4 w; w.x = cvt_pk_bf16(v0[0], v0[1]); w.y = cvt_pk_bf16(v0[2], v0[3]); w.z = cvt_pk_bf16(v1[0], v1[1]); w.w = cvt_pk_bf16(v1[2], v1[3]);
                    *(u32x4*)(rowp + bj * 2 * 16384) = w; } }
    }
};
struct EpiBias {
    static constexpr bool PERM = true, HOOK = false;
    float* out; int ldo;
    __device__ __forceinline__ void operator()(const f32x4 (&acc)[2][2][4][2], const Unit& u, int wr, int wc, int fr, int fq) const {
        const int col0 = u.pn * 256 + wc * 32 + 8 * fq;
        if (wr == 0) {
#pragma unroll
            for (int m = 0; m < 3; ++m) { const int row = m * 16 + fr;
                if (row < 33) {
#pragma unroll
                    for (int bj = 0; bj < 2; ++bj) { *(f32x4*)(out + (size_t)row * ldo + col0 + bj * 128) = acc[0][bj][m][0]; *(f32x4*)(out + (size_t)row * ldo + col0 + bj * 128 + 4) = acc[0][bj][m][1]; } } }
        }
    }
};
}

struct Args {
    const float* in[22];
    float* out; unsigned char* ws;
    int ph_lo, ph_hi;
};

__device__ __forceinline__ void transpose_item(const float* W, int ldw, bf16* WT, int ldwt, int kofs, int k0, int nsrc0, int ndst0, LAS float* scr, int lane) {
#pragma unroll 8
    for (int i = 0; i < 32; ++i) { const int kk = 2 * i + (lane >> 5); scr[kk * 33 + (lane & 31)] = W[(size_t)(k0 + kk) * ldw + nsrc0 + (lane & 31)]; }
    asm volatile("s_waitcnt lgkmcnt(0)" ::: "memory");
    const int c = lane & 7;
#pragma unroll
    for (int j = 0; j < 4; ++j) { const int n = (lane >> 3) + 8 * j; const LAS float* s = scr + (8 * c) * 33 + n;
        u32x4 o; o.x = cvt_pk_bf16(s[0 * 33], s[1 * 33]); o.y = cvt_pk_bf16(s[2 * 33], s[3 * 33]); o.z = cvt_pk_bf16(s[4 * 33], s[5 * 33]); o.w = cvt_pk_bf16(s[6 * 33], s[7 * 33]);
        *(u32x4*)(WT + (size_t)(ndst0 + n) * ldwt + kofs + k0 + 8 * c) = o; }
    asm volatile("s_waitcnt lgkmcnt(0)" ::: "memory");
}
__device__ __forceinline__ int inproj_src_col(int n) {
    if (n < 128) return 384 + n;
    if (n < 256) return 512 + (n - 128);
    if (n < 384) return 1024 + (n - 256);
    if (n < 512) return 1152 + (n - 384);
    if (n < 896) return n - 512;
    if (n < 1280) return 640 + (n - 896);
    return n;
}
__device__ __forceinline__ void sincos_d(double a, float& s, float& c) {
    const double twopi = 6.283185307179586476925286766559;
    const double k = __builtin_rint(a / twopi);
    double r = a - k * twopi;
    r *= 0.25;
    const double r2 = r * r;
    double sn = r * (1.0 + r2 * (-1.0 / 6 + r2 * (1.0 / 120 + r2 * (-1.0 / 5040 + r2 * (1.0 / 362880 + r2 * (-1.0 / 39916800 + r2 * (1.0 / 6227020800.0)))))));
    double cs = 1.0 + r2 * (-0.5 + r2 * (1.0 / 24 + r2 * (-1.0 / 720 + r2 * (1.0 / 40320 + r2 * (-1.0 / 3628800 + r2 * (1.0 / 479001600.0 + r2 * (-1.0 / 87178291200.0)))))));
#pragma unroll
    for (int i = 0; i < 2; ++i) { const double s2 = 2.0 * sn * cs, c2 = cs * cs - sn * sn; sn = s2; cs = c2; }
    s = (float)sn; c = (float)cs;
}

__device__ __forceinline__ void phase_prologue(const Args& a, LAS unsigned char* lds, int tid, int wave, int lane, int G) {
    unsigned char* ws = a.ws;
    const int bx = blockIdx.x;
    if (bx < 192) {
        LAS float* silu = (LAS float*)lds;
        LAS float* red = (LAS float*)(lds + 33 * 1024 * 4);
        const float* cin = a.in[1]; const float* cctx = a.in[3];
        for (int i = tid; i < 33 * 1024; i += NTHR) { const float v = i < 32 * 1024 ? cin[i] : cctx[i - 32 * 1024]; silu[i] = v * __builtin_amdgcn_rcpf(1.0f + __expf(-v)); }
        __syncthreads();
        const int l = bx / 96, colblk = bx % 96;
        const float* wa = a.in[4] + (size_t)l * 1024 * 6144; const float* ba = a.in[5] + (size_t)l * 6144;
        float* modl = (float*)(ws + WS_MOD) + (size_t)l * 33 * 6144;
        float acc[33];
#pragma unroll
        for (int r = 0; r < 33; ++r) acc[r] = 0.f;
        const float* wp = wa + (size_t)(wave * 128) * 6144 + colblk * 64 + lane;
        for (int k = 0; k < 128; k += 4) {
            const float w0 = wp[(size_t)(k + 0) * 6144], w1 = wp[(size_t)(k + 1) * 6144], w2 = wp[(size_t)(k + 2) * 6144], w3 = wp[(size_t)(k + 3) * 6144];
#pragma unroll
            for (int r = 0; r < 33; ++r) { const f32x4 s = *(const LAS f32x4*)(silu + r * 1024 + wave * 128 + k); acc[r] += s.x * w0 + s.y * w1 + s.z * w2 + s.w * w3; }
        }
        for (int w = 0; w < 8; ++w) {
            if (wave == w) {
#pragma unroll
                for (int r = 0; r < 33; ++r) { if (w == 0) red[r * 64 + lane] = acc[r]; else red[r * 64 + lane] += acc[r]; } }
            __syncthreads();
        }
        { const int vidx = colblk >> 4;
          float* AVb = (float*)(ws + WS_AV); bf16* SHb = (bf16*)(ws + WS_SH);
          for (int i = tid; i < 33 * 64; i += NTHR) { const int r = i >> 6, cc = i & 63; const int col = (colblk & 15) * 64 + cc;
            const float val = red[i] + ba[colblk * 64 + cc];
            modl[(size_t)r * 6144 + colblk * 64 + cc] = val;
            if (vidx == 1) AVb[((size_t)(l * 2 + 0) * 33 + r) * 1024 + col] = a.in[6][l * 1024 + col] * (1.0f + val);
            if (vidx == 4) AVb[((size_t)(l * 2 + 1) * 33 + r) * 1024 + col] = a.in[7][l * 1024 + col] * (1.0f + val);
            if (vidx == 0 && l == 1) SHb[blk_off(r, col, 1024)] = (bf16)(cvt_pk_bf16(val, 0.f) & 0xffffu);
            if (vidx == 3) SHb[(size_t)(1 + l) * 256 * 1024 + blk_off(r, col, 1024)] = (bf16)(cvt_pk_bf16(val, 0.f) & 0xffffu); } }
        __syncthreads();
    } else {
        LAS float* wps = (LAS float*)lds;
        for (int it = bx - 192; it < 128; it += 64) {
            const int l = it >> 6, g = (it >> 4) & 3, nb = it & 15;
            const float* wpool = a.in[14] + ((size_t)l * 4 + g) * 4096; const float* ps = a.in[15] + (size_t)l * 256 + g * 64;
            const float* wbb = a.in[17] + (size_t)l * 256 * 1024 + (size_t)(g * 64) * 1024 + nb * 64;
            bf16* WbrT = (bf16*)(ws + WS_W + l * WL_SIZE + WL_BR);
            for (int i = tid; i < 4096; i += NTHR) wps[i] = wpool[i] * ps[i & 63];
            __syncthreads();
            float acc[8];
#pragma unroll
            for (int ci = 0; ci < 8; ++ci) acc[ci] = 0.f;
            for (int d = 0; d < 64; ++d) { const float b = wbb[(size_t)d * 1024 + lane];
#pragma unroll
                for (int ci = 0; ci < 8; ++ci) acc[ci] += wps[(wave * 8 + ci) * 64 + d] * b; }
            u32x4 o; o.x = cvt_pk_bf16(acc[0], acc[1]); o.y = cvt_pk_bf16(acc[2], acc[3]); o.z = cvt_pk_bf16(acc[4], acc[5]); o.w = cvt_pk_bf16(acc[6], acc[7]);
            *(u32x4*)(WbrT + (size_t)(nb * 64 + lane) * 1024 + 384 + g * 64 + wave * 8) = o;
            __syncthreads();
        }
    }
    { float* rssb = (float*)(ws + WS_RSS); for (int i = bx * NTHR + tid; i < 3 * TT; i += G * NTHR) rssb[i] = 0.f; }
    {
        float* cs = (float*)(ws + WS_ROPE); float* sn = cs + 2048 * 32;
        for (int i = bx * NTHR + tid; i < 2048 * 32; i += G * NTHR) {
            const int t = i >> 5, j = i & 31; const int jj = j & 15;
            const float inv = 1.0f / powf(10000.0f, (float)(2 * jj) / 32.0f);
            const float pos = (float)(j < 16 ? (t >> 6) : (t & 63));
            const float ang = pos * inv;
            float s, c; sincos_d((double)ang, s, c); cs[i] = c; sn[i] = s;
        }
    }
    {
        LAS float* scr = (LAS float*)(lds + wave * 16384);
        const int gw = bx * NWAVES + wave, NGW = G * NWAVES;
        for (int it = gw; it < 2 * 7296; it += NGW) {
            const int l = it / 7296; int r = it - l * 7296;
            unsigned char* wl = ws + WS_W + l * WL_SIZE;
            if (r < 2304) { const int kb = r / 144, nb = r % 144; transpose_item(a.in[8] + (size_t)l * 1024 * INW, INW, (bf16*)(wl + WL_IN), 1024, 0, kb * 64, inproj_src_col(nb * 32), nb * 32, scr, lane); continue; } r -= 2304;
            if (r < 2048) { const int kb = r / 128, nb = r % 128; transpose_item(a.in[20] + (size_t)l * 1024 * FF, FF, (bf16*)(wl + WL_W1), 1024, 0, kb * 64, nb * 32, nb * 32, scr, lane); continue; } r -= 2048;
            if (r < 2048) { const int kb = r / 32, nb = r % 32; transpose_item(a.in[21] + (size_t)l * FF * 1024, 1024, (bf16*)(wl + WL_W2), FF, 0, kb * 64, nb * 32, nb * 32, scr, lane); continue; } r -= 2048;
            if (r < 512) { const int kb = r / 32, nb = r % 32; transpose_item(a.in[19] + (size_t)l * 1024 * 1024, 1024, (bf16*)(wl + WL_WO), 1024, 0, kb * 64, nb * 32, nb * 32, scr, lane); continue; } r -= 512;
            if (r < 192) { const int kb = r / 32, nb = r % 32; transpose_item(a.in[16] + (size_t)l * 384 * 1024, 1024, (bf16*)(wl + WL_BR), 1024, 0, kb * 64, nb * 32, nb * 32, scr, lane); continue; } r -= 192;
            { const int kb = r / 32, nb = r % 32; transpose_item(a.in[18] + (size_t)l * 384 * 1024, 1024, (bf16*)(wl + WL_BR), 1024, 640, kb * 64, nb * 32, nb * 32, scr, lane); }
        }
    }
}

__device__ __forceinline__ void phase_norm(const float* src_lat, const float* src_ctx, const float* normw, const float* modl, int sh_idx, int sc_idx, bf16* H, int nrows, int gw, int NGW, int lane) {
    for (int row = gw; row < nrows; row += NGW) {
        const bool isctx = row >= TL; const int r = isctx ? 32 : (row >> 11);
        const float* xr = isctx ? src_ctx + (size_t)(row - TL) * 1024 : src_lat + (size_t)row * 1024;
        const f32x4* xp = (const f32x4*)xr + lane;
        f32x4 v[4]; float ss = 0.f;
#pragma unroll
        for (int j = 0; j < 4; ++j) { v[j] = xp[64 * j]; ss += (v[j].x * v[j].x + v[j].y * v[j].y) + (v[j].z * v[j].z + v[j].w * v[j].w); }
        const float rstd = rsqrtf(wave_sum(ss) * (1.0f / 1024.0f) + EPS);
        const f32x4* wp = (const f32x4*)normw + lane; const f32x4* scp = (const f32x4*)(modl + (size_t)r * 6144 + sc_idx * 1024) + lane; const f32x4* shp = (const f32x4*)(modl + (size_t)r * 6144 + sh_idx * 1024) + lane;
#pragma unroll
        for (int j = 0; j < 4; ++j) { const f32x4 w = wp[64 * j], sc = scp[64 * j], sh = shp[64 * j];
            const f32x4 h = (v[j] * rstd) * w * (sc + 1.0f) + sh;
            *(unsigned long long*)(H + blk_off(row, 4 * (lane + 64 * j), 1024)) = (unsigned long long)cvt_pk_bf16(h.x, h.y) | ((unsigned long long)cvt_pk_bf16(h.z, h.w) << 32); }
    }
}

__device__ __forceinline__ void phase_qkvpool(const Args& a, int layer, LAS unsigned char* lds, int tid, int wave, int lane, int vcu, int G) {
    unsigned char* ws = a.ws;
    const bf16* ZQ = (const bf16*)(ws + WS_ZQ); bf16* OCAT = (bf16*)(ws + WS_B1); bf16* KB = (bf16*)(ws + WS_K); bf16* VT = (bf16*)(ws + WS_VT);
    const float* cosT = (const float*)(ws + WS_ROPE); const float* sinT = cosT + 2048 * 32;
    const float* kn_a = a.in[10] + layer * 64; const float* kn_c = a.in[12] + layer * 64;
    LAS bf16* Vs = (LAS bf16*)lds;
    LAS bf16* Us = (LAS bf16*)(lds + 64 * 264 * 2);
    const bool last = layer == 1;
    const int tk0 = tid >> 4, hs = (tid >> 2) & 3, qd = tid & 3;
    const int kcol = (hs < 2 ? ZC_KA + hs * 64 : ZC_KC + (hs - 2) * 64) + qd * 16;
    const int kbr = hs >> 1, khk = hs & 1;
    f32x4 gq[4];
    { const float* gwp = hs < 2 ? kn_a : kn_c;
#pragma unroll
      for (int j = 0; j < 4; ++j) gq[j] = *(const f32x4*)(gwp + qd * 16 + 4 * j); }
    for (int ch = vcu; ch < TT / 64; ch += G) {
        const int row0 = ch * 64; const bool isctx = row0 >= TL;
        const int b = isctx ? (row0 - TL) / CTXL : row0 / SEQ;
        const int t0 = isctx ? (row0 - TL) % CTXL : row0 % SEQ;
        const int nseq = isctx ? CTXL : SEQ; const int seqrow0 = row0 - t0;
        const int keybase = isctx ? t0 : CTXL + t0;
        const bool dopool = !(isctx && last);
        u32x4 kr[2][2], vr[4], ur[5];
#pragma unroll
        for (int i = 0; i < 2; ++i) { const bf16* p = ZQ + (size_t)(row0 + tk0 + 32 * i) * ZQW + kcol; kr[i][0] = *(const u32x4*)p; kr[i][1] = *(const u32x4*)(p + 8); }
#pragma unroll
        for (int i = 0; i < 4; ++i) { const int idx = tid + NTHR * i; const int tok = idx >> 5, c8 = (idx & 31) * 8; const int zc = c8 < 128 ? ZC_VA + c8 : ZC_VC + (c8 - 128);
            vr[i] = *(const u32x4*)(ZQ + (size_t)(row0 + tok) * ZQW + zc); }
        if (dopool) {
#pragma unroll
            for (int i = 0; i < 5; ++i) { const int idx = tid + NTHR * i; const int tr = idx >> 5, c8 = (idx & 31) * 8; const int tl = t0 - 8 + tr;
                ur[i] = (u32x4){0u, 0u, 0u, 0u}; if (tl >= 0 && tl < nseq) ur[i] = *(const u32x4*)(ZQ + (size_t)(seqrow0 + tl) * ZQW + ZC_U + c8); } }
#pragma unroll
        for (int i = 0; i < 4; ++i) { const int idx = tid + NTHR * i; const int tok = idx >> 5, c8 = (idx & 31) * 8; *(LAS u32x4*)(Vs + tok * 264 + c8) = vr[i]; }
        if (dopool) {
#pragma unroll
            for (int i = 0; i < 5; ++i) { const int idx = tid + NTHR * i; const int tr = idx >> 5, c8 = (idx & 31) * 8; *(LAS u32x4*)(Us + tr * 264 + c8) = ur[i]; } }
#pragma unroll
        for (int i = 0; i < 2; ++i) {
            const int tt = tk0 + 32 * i;
            const u32x4 ua = kr[i][0], ub = kr[i][1];
            float v[16];
            v[0] = bf_lo(ua.x); v[1] = bf_hi(ua.x); v[2] = bf_lo(ua.y); v[3] = bf_hi(ua.y); v[4] = bf_lo(ua.z); v[5] = bf_hi(ua.z); v[6] = bf_lo(ua.w); v[7] = bf_hi(ua.w);
            v[8] = bf_lo(ub.x); v[9] = bf_hi(ub.x); v[10] = bf_lo(ub.y); v[11] = bf_hi(ub.y); v[12] = bf_lo(ub.z); v[13] = bf_hi(ub.z); v[14] = bf_lo(ub.w); v[15] = bf_hi(ub.w);
            float ss = 0.f;
#pragma unroll
            for (int j = 0; j < 16; ++j) ss += v[j] * v[j];
            ss += __shfl_xor(ss, 1); ss += __shfl_xor(ss, 2);
            const float rstd = rsqrtf(ss * (1.0f / 64.0f) + EPS);
#pragma unroll
            for (int j = 0; j < 16; ++j) v[j] = v[j] * rstd * gq[j >> 2][j & 3];
            if (!isctx) {
                const int t = t0 + tt;
                const f32x4 c0 = *(const f32x4*)(cosT + t * 32 + qd * 8), c1 = *(const f32x4*)(cosT + t * 32 + qd * 8 + 4);
                const f32x4 s0 = *(const f32x4*)(sinT + t * 32 + qd * 8), s1 = *(const f32x4*)(sinT + t * 32 + qd * 8 + 4);
#pragma unroll
                for (int pi = 0; pi < 8; ++pi) { const float cs = pi < 4 ? c0[pi & 3] : c1[pi & 3], sn = pi < 4 ? s0[pi & 3] : s1[pi & 3];
                    const float x0 = v[2 * pi], x1 = v[2 * pi + 1]; v[2 * pi] = x0 * cs - x1 * sn; v[2 * pi + 1] = x0 * sn + x1 * cs; }
            }
            u32x4 oa, ob;
            oa.x = cvt_pk_bf16(v[0], v[1]); oa.y = cvt_pk_bf16(v[2], v[3]); oa.z = cvt_pk_bf16(v[4], v[5]); oa.w = cvt_pk_bf16(v[6], v[7]);
            ob.x = cvt_pk_bf16(v[8], v[9]); ob.y = cvt_pk_bf16(v[10], v[11]); ob.z = cvt_pk_bf16(v[12], v[13]); ob.w = cvt_pk_bf16(v[14], v[15]);
            bf16* kp = KB + ((size_t)((kbr * NB + b) * 2 + khk) * NKEY + keybase + tt) * 64 + qd * 16; *(u32x4*)kp = oa; *(u32x4*)(kp + 8) = ob;
        }
        __syncthreads();
#pragma unroll
        for (int ii = 0; ii < 4; ++ii) { const int i = tid + NTHR * ii; const int cc = i >> 3, pc = i & 7; const int mat = cc >> 6, d = cc & 63; const int br = mat >> 1, hk = mat & 1;
            unsigned short e[8];
#pragma unroll
            for (int j = 0; j < 8; ++j) { const int p = 8 * pc + j, q = p & 15; const int key = (p & ~15) + (q & 3) + 8 * ((q >> 2) & 1) + 4 * (q >> 3); e[j] = Vs[key * 264 + cc]; }
            u32x4 o; o.x = e[0] | ((unsigned)e[1] << 16); o.y = e[2] | ((unsigned)e[3] << 16); o.z = e[4] | ((unsigned)e[5] << 16); o.w = e[6] | ((unsigned)e[7] << 16);
            *(u32x4*)(VT + ((size_t)((br * NB + b) * 2 + hk) * 64 + d) * NKEY + keybase + 8 * pc) = o; }
        if (dopool) {
#pragma unroll
            for (int ii = 0; ii < 4; ++ii) { const int i = tid + NTHR * ii; const int tok = i >> 5, c8 = (i & 31) * 8; const int gi = c8 >> 6; const int hw = 1 << gi;
                const int tl = t0 + tok; const int lo = max(tl - hw, 0), hi = min(tl + hw, nseq);
                float s[8];
#pragma unroll
                for (int j = 0; j < 8; ++j) s[j] = 0.f;
                for (int tq = lo; tq < hi; ++tq) { const u32x4 v = *(const LAS u32x4*)(Us + (tq - t0 + 8) * 264 + c8);
                    s[0] += bf_lo(v.x); s[1] += bf_hi(v.x); s[2] += bf_lo(v.y); s[3] += bf_hi(v.y); s[4] += bf_lo(v.z); s[5] += bf_hi(v.z); s[6] += bf_lo(v.w); s[7] += bf_hi(v.w); }
                const float ic = 1.0f / (float)(hi - lo);
                const u32x4 uu = *(const LAS u32x4*)(Us + (tok + 8) * 264 + c8);
                u32x4 o;
                o.x = cvt_pk_bf16(s[0] * ic - bf_lo(uu.x), s[1] * ic - bf_hi(uu.x)); o.y = cvt_pk_bf16(s[2] * ic - bf_lo(uu.y), s[3] * ic - bf_hi(uu.y));
                o.z = cvt_pk_bf16(s[4] * ic - bf_lo(uu.z), s[5] * ic - bf_hi(uu.z)); o.w = cvt_pk_bf16(s[6] * ic - bf_lo(uu.w), s[7] * ic - bf_hi(uu.w));
                *(u32x4*)(OCAT + blk_off(row0 + tok, 384 + c8, 1024)) = o; } }
        __syncthreads();
    }
}

__device__ __forceinline__ void attn_load_q(const bf16* qrow, const float* qnw, const float* cosT, int t, bool rope, int h, bf16x8 (&qf)[4]) {
    u32x4 qr[4];
#pragma unroll
    for (int ds = 0; ds < 4; ++ds) qr[ds] = *(const u32x4*)(qrow + ds * 16);
    float v[32]; float ss = 0.f;
#pragma unroll
    for (int ds = 0; ds < 4; ++ds) { v[8 * ds + 0] = bf_lo(qr[ds].x); v[8 * ds + 1] = bf_hi(qr[ds].x); v[8 * ds + 2] = bf_lo(qr[ds].y); v[8 * ds + 3] = bf_hi(qr[ds].y);
        v[8 * ds + 4] = bf_lo(qr[ds].z); v[8 * ds + 5] = bf_hi(qr[ds].z); v[8 * ds + 6] = bf_lo(qr[ds].w); v[8 * ds + 7] = bf_hi(qr[ds].w); }
#pragma unroll
    for (int j = 0; j < 32; ++j) ss += v[j] * v[j];
    ss += __shfl_xor(ss, 32);
    const float rstd = rsqrtf(ss * (1.0f / 64.0f) + EPS);
#pragma unroll
    for (int ds = 0; ds < 4; ++ds) { const f32x4 g0 = *(const f32x4*)(qnw + ds * 16 + h * 8), g1 = *(const f32x4*)(qnw + ds * 16 + h * 8 + 4);
#pragma unroll
        for (int j = 0; j < 4; ++j) { v[8 * ds + j] = v[8 * ds + j] * rstd * g0[j]; v[8 * ds + 4 + j] = v[8 * ds + 4 + j] * rstd * g1[j]; } }
    if (rope) {
#pragma unroll
        for (int ds = 0; ds < 4; ++ds) { const f32x4 cs = *(const f32x4*)(cosT + t * 32 + 8 * ds + 4 * h), sn = *(const f32x4*)(cosT + 2048 * 32 + t * 32 + 8 * ds + 4 * h);
#pragma unroll
            for (int jp = 0; jp < 4; ++jp) { const float x0 = v[8 * ds + 2 * jp], x1 = v[8 * ds + 2 * jp + 1]; v[8 * ds + 2 * jp] = x0 * cs[jp] - x1 * sn[jp]; v[8 * ds + 2 * jp + 1] = x0 * sn[jp] + x1 * cs[jp]; } } }
#pragma unroll
    for (int ds = 0; ds < 4; ++ds) { u32x4 w; w.x = cvt_pk_bf16(v[8 * ds + 0] * QSCALE, v[8 * ds + 1] * QSCALE); w.y = cvt_pk_bf16(v[8 * ds + 2] * QSCALE, v[8 * ds + 3] * QSCALE);
        w.z = cvt_pk_bf16(v[8 * ds + 4] * QSCALE, v[8 * ds + 5] * QSCALE); w.w = cvt_pk_bf16(v[8 * ds + 6] * QSCALE, v[8 * ds + 7] * QSCALE); qf[ds] = __builtin_bit_cast(bf16x8, w); }
}
__device__ __forceinline__ void attn_unit(LAS unsigned char* lds, const bf16* Qp, int ldq, const bf16* Kp, const bf16* Vtp, bf16* Op, int ldo,
                                          int lat_t0, int lat_t1, bool band, int q0, float sink_l2, bool use_sink, const float* qnw, const float* knw, const float* cosT, int qpos0, int nact, int tid, int wave, int lane) {
    const int c = lane & 31, h = lane >> 5;
    const bool active = wave < nact;
    u32x4 kreg, vreg;
    const int skey = tid >> 3, sch8 = (tid & 7) * 8;
    const unsigned kvoff = (unsigned)(skey * 64 + sch8) * 2u, vvoff = (unsigned)(skey * NKEY + sch8) * 2u;
    const int lsoff = skey * 72 + sch8;
#define ATT_KB(it_) ((it_) < 4 ? (it_) * 64 : CTXL + (lat_t0 + (it_) - 4) * 64)
#define ATT_LOAD(kr, vr, kb_) do { kr = *(const u32x4*)((const char*)(Kp + (size_t)(kb_) * 64) + kvoff); vr = *(const u32x4*)((const char*)(Vtp + (kb_)) + vvoff); } while (0)
    ATT_LOAD(kreg, vreg, 0);
    bf16x8 qfa[4], qfb[4];
    {   const int r0 = active ? wave * 64 + c : c;
        attn_load_q(Qp + (size_t)r0 * ldq + h * 8, qnw, cosT, qpos0 + r0, qpos0 >= 0, h, qfa);
        attn_load_q(Qp + (size_t)(r0 + 32) * ldq + h * 8, qnw, cosT, qpos0 + r0 + 32, qpos0 >= 0, h, qfb); }
    f32x16 oa0, oa1, ob0, ob1;
#pragma unroll
    for (int i = 0; i < 16; ++i) { oa0[i] = 0.f; oa1[i] = 0.f; ob0[i] = 0.f; ob1[i] = 0.f; }
    float gmax = fabsf(qnw[lane]), kmax = fabsf(knw[lane]);
#pragma unroll
    for (int o = 1; o < 64; o <<= 1) { gmax = fmaxf(gmax, __shfl_xor(gmax, o)); kmax = fmaxf(kmax, __shfl_xor(kmax, o)); }
    float M = 64.0f * 1.03f * QSCALE * gmax * kmax;
    if (use_sink) M = fmaxf(M, sink_l2);
    float la = (use_sink && h == 0) ? fast_exp2(sink_l2 - M) : 0.0f, lb = la;
    const float negM = -M;
    const int ntiles = 4 + (lat_t1 - lat_t0);
    constexpr int KSZ = 64 * 72, BUFSZ = 2 * KSZ;
    LAS bf16* Ls = (LAS bf16*)lds;
#define ATT_PK(dst, src, o_) do { u32x4 w_; w_.x = cvt_pk_bf16(src[o_ + 0], src[o_ + 1]); w_.y = cvt_pk_bf16(src[o_ + 2], src[o_ + 3]); w_.z = cvt_pk_bf16(src[o_ + 4], src[o_ + 5]); w_.w = cvt_pk_bf16(src[o_ + 6], src[o_ + 7]); dst = __builtin_bit_cast(bf16x8, w_); } while (0)
#define ATT_PVJ(j, sa_, sb_, o_) do { bf16x8 pa_, pb_; ATT_PK(pa_, sa_, o_); ATT_PK(pb_, sb_, o_); \
                oa0 = __builtin_amdgcn_mfma_f32_32x32x16_bf16(vf[2 * (j)], pa_, oa0, 0, 0, 0); oa1 = __builtin_amdgcn_mfma_f32_32x32x16_bf16(vf[2 * (j) + 1], pa_, oa1, 0, 0, 0); \
                ob0 = __builtin_amdgcn_mfma_f32_32x32x16_bf16(vf[2 * (j)], pb_, ob0, 0, 0, 0); ob1 = __builtin_amdgcn_mfma_f32_32x32x16_bf16(vf[2 * (j) + 1], pb_, ob1, 0, 0, 0); } while (0)
    auto tile_step = [&](int it, u32x4& KR, u32x4& VR) __attribute__((always_inline)) {
        LAS bf16* Ks = Ls + (it & 1) * BUFSZ; LAS bf16* Vs = Ks + KSZ;
        __syncthreads();
        if (it + 1 < ntiles) { LAS bf16* Kn = Ls + ((it + 1) & 1) * BUFSZ; *(LAS u32x4*)(Kn + lsoff) = KR; *(LAS u32x4*)(Kn + KSZ + lsoff) = VR;
            if (it + 2 < ntiles) ATT_LOAD(KR, VR, ATT_KB(it + 2)); }
        bool need = active, domask = false;
        if (band && it >= 4) { const int kp0 = (lat_t0 + it - 4) * 64, qa = q0 + wave * 64;
            need = need && (kp0 <= qa + 63 + 128) && (kp0 + 63 >= qa - 128);
            domask = !((kp0 >= qa + 63 - 128) && (kp0 + 63 <= qa + 128)); }
        if (need) {
            const LAS bf16* kt = Ks + c * 72 + h * 8;
            const LAS bf16* vt = Vs + c * 72 + h * 8;
            bf16x8 kf[8];
#pragma unroll
            for (int ds = 0; ds < 2; ++ds) { kf[2 * ds] = *(const LAS bf16x8*)(kt + ds * 16); kf[2 * ds + 1] = *(const LAS bf16x8*)(kt + 32 * 72 + ds * 16); }
            __builtin_amdgcn_sched_barrier(0);
            f32x16 sa0, sa1, sb0, sb1;
            f32x16 cinit; { float nm_ = negM; asm volatile("" : "+v"(nm_));
#pragma unroll
              for (int i = 0; i < 16; ++i) cinit[i] = nm_; }
            sa0 = __builtin_amdgcn_mfma_f32_32x32x16_bf16(kf[0], qfa[0], cinit, 0, 0, 0); sa1 = __builtin_amdgcn_mfma_f32_32x32x16_bf16(kf[1], qfa[0], cinit, 0, 0, 0);
            sb0 = __builtin_amdgcn_mfma_f32_32x32x16_bf16(kf[0], qfb[0], cinit, 0, 0, 0); sb1 = __builtin_amdgcn_mfma_f32_32x32x16_bf16(kf[1], qfb[0], cinit, 0, 0, 0);
#pragma unroll
            for (int ds = 2; ds < 4; ++ds) { kf[2 * ds] = *(const LAS bf16x8*)(kt + ds * 16); kf[2 * ds + 1] = *(const LAS bf16x8*)(kt + 32 * 72 + ds * 16); }
#pragma unroll
            for (int ds = 1; ds < 4; ++ds) {
                sa0 = __builtin_amdgcn_mfma_f32_32x32x16_bf16(kf[2 * ds], qfa[ds], sa0, 0, 0, 0); sa1 = __builtin_amdgcn_mfma_f32_32x32x16_bf16(kf[2 * ds + 1], qfa[ds], sa1, 0, 0, 0);
                sb0 = __builtin_amdgcn_mfma_f32_32x32x16_bf16(kf[2 * ds], qfb[ds], sb0, 0, 0, 0); sb1 = __builtin_amdgcn_mfma_f32_32x32x16_bf16(kf[2 * ds + 1], qfb[ds], sb1, 0, 0, 0); }
            __builtin_amdgcn_sched_barrier(0);
            if (domask) { const int kp = (lat_t0 + it - 4) * 64 + 4 * h - (q0 + wave * 64 + c) + 128;
#pragma unroll
                for (int i = 0; i < 16; ++i) { const unsigned d0 = (unsigned)(kp + (i & 3) + 8 * (i >> 2)), d1 = d0 + 32u, e0 = d0 - 32u, e1 = d0;
                    if (d0 > 256u) sa0[i] = -1e30f;
                    if (d1 > 256u) sa1[i] = -1e30f;
                    if (e0 > 256u) sb0[i] = -1e30f;
                    if (e1 > 256u) sb1[i] = -1e30f; } }
            float pa0 = 0.f, pa1 = 0.f, pb0 = 0.f, pb1 = 0.f;
#pragma unroll
            for (int i = 0; i < 16; ++i) { sa0[i] = fast_exp2(sa0[i]); sa1[i] = fast_exp2(sa1[i]); sb0[i] = fast_exp2(sb0[i]); sb1[i] = fast_exp2(sb1[i]); pa0 += sa0[i]; pa1 += sa1[i]; pb0 += sb0[i]; pb1 += sb1[i]; }
            la += pa0 + pa1; lb += pb0 + pb1;
            __builtin_amdgcn_sched_barrier(0);
            bf16x8 vf[8];
#pragma unroll
            for (int j = 0; j < 4; ++j) { vf[2 * j] = *(const LAS bf16x8*)(vt + j * 16); vf[2 * j + 1] = *(const LAS bf16x8*)(vt + 32 * 72 + j * 16); }
            ATT_PVJ(0, sa0, sb0, 0); ATT_PVJ(1, sa0, sb0, 8); ATT_PVJ(2, sa1, sb1, 0); ATT_PVJ(3, sa1, sb1, 8);
        }
    };
    *(LAS u32x4*)(Ls + lsoff) = kreg; *(LAS u32x4*)(Ls + KSZ + lsoff) = vreg;
    ATT_LOAD(kreg, vreg, ATT_KB(1));
    for (int it = 0; it < ntiles; ++it) tile_step(it, kreg, vreg);
#undef ATT_PVJ
#undef ATT_PK
#undef ATT_KB
#undef ATT_LOAD
    const float lta = la + __shfl_xor(la, 32), ltb = lb + __shfl_xor(lb, 32);
    const float inva = 1.0f / lta, invb = 1.0f / ltb;
    __syncthreads();
    if (active) {
        LAS bf16* osw = (LAS bf16*)(lds + 36864 + wave * 9216);
#pragma unroll
        for (int g4 = 0; g4 < 4; ++g4) {
            u32x2 w0, w1;
            w0.x = cvt_pk_bf16(oa0[4 * g4] * inva, oa0[4 * g4 + 1] * inva); w0.y = cvt_pk_bf16(oa0[4 * g4 + 2] * inva, oa0[4 * g4 + 3] * inva);
            w1.x = cvt_pk_bf16(oa1[4 * g4] * inva, oa1[4 * g4 + 1] * inva); w1.y = cvt_pk_bf16(oa1[4 * g4 + 2] * inva, oa1[4 * g4 + 3] * inva);
            *(LAS u32x2*)(osw + c * 72 + 4 * h + 8 * g4) = w0; *(LAS u32x2*)(osw + c * 72 + 4 * h + 32 + 8 * g4) = w1;
            w0.x = cvt_pk_bf16(ob0[4 * g4] * invb, ob0[4 * g4 + 1] * invb); w0.y = cvt_pk_bf16(ob0[4 * g4 + 2] * invb, ob0[4 * g4 + 3] * invb);
            w1.x = cvt_pk_bf16(ob1[4 * g4] * invb, ob1[4 * g4 + 1] * invb); w1.y = cvt_pk_bf16(ob1[4 * g4 + 2] * invb, ob1[4 * g4 + 3] * invb);
            *(LAS u32x2*)(osw + (32 + c) * 72 + 4 * h + 8 * g4) = w0; *(LAS u32x2*)(osw + (32 + c) * 72 + 4 * h + 32 + 8 * g4) = w1;
        }
        asm volatile("s_waitcnt lgkmcnt(0)" ::: "memory");
        const int wrow0 = wave * 64;
        char* ob = (char*)(Op + (size_t)(wrow0 >> 8) * 16 * 16384 + (size_t)(wrow0 & 255) * 64);
        int ln_ = lane; asm volatile("" : "+v"(ln_));
        const unsigned ovoff = (unsigned)((ln_ >> 3) * 64 + (ln_ & 7) * 8) * 2u;
#pragma unroll
        for (int j = 0; j < 8; ++j) { const int row = (ln_ >> 3) + 8 * j, ch = ln_ & 7;
            const u32x4 v = *(const LAS u32x4*)(osw + row * 72 + ch * 8);
            *(u32x4*)(ob + ovoff + (unsigned)(j * 8 * 64 * 2)) = v; }
        asm volatile("s_waitcnt lgkmcnt(0)" ::: "memory");
    }
}

__device__ __forceinline__ void phase_attn(const Args& a, int layer, LAS unsigned char* lds, int tid, int wave, int lane, int vcu, int G) {
    unsigned char* ws = a.ws;
    const bf16* ZQ = (const bf16*)(ws + WS_ZQ); bf16* OCAT = (bf16*)(ws + WS_B1); const bf16* KB = (const bf16*)(ws + WS_K); const bf16* VT = (const bf16*)(ws + WS_VT);
    const float* sink = a.in[13] + layer * 6; const float* cosT = (const float*)(ws + WS_ROPE);
    const float* qn_a = a.in[9] + layer * 64; const float* qn_c = a.in[11] + layer * 64; const float* kn_a = a.in[10] + layer * 64; const float* kn_c = a.in[12] + layer * 64;
    const int nunits = layer == 0 ? 1536 + 384 : 1536;
    for (int p = vcu; p < nunits; p += G) {
        int br, b, head, row0, lat0 = 0, lat1 = 0, q0 = 0, qpos0 = -1, nact = 8; bool band = false, use_sink = false;
        if (p < 1536) {
            br = p >= 768 ? 1 : 0; const int pp = p - br * 768;
            const int qb = pp & 3, g = (pp >> 2) % 3, bhk = pp / 12; b = bhk >> 1; head = (bhk & 1) * 3 + g;
            q0 = qb * 512; row0 = b * SEQ + q0; qpos0 = q0;
            if (br == 0) { lat0 = 0; lat1 = 32; }
            else { lat0 = max(q0 - 128, 0) / 64; lat1 = min(q0 + 512 + 128, SEQ) / 64; band = true; use_sink = true; }
        } else {
            const int pp = p - 1536; br = pp >= 192 ? 1 : 0; const int q = pp - br * 192; b = q / 6; head = q % 6;
            row0 = TL + b * CTXL; use_sink = br != 0; nact = 4;
        }
        const int hk = head / 3;
        const bf16* Qp = ZQ + (size_t)row0 * ZQW + (br ? ZC_QC : ZC_QA) + head * 64;
        const size_t kvi = (size_t)((br * NB + b) * 2 + hk);
        bf16* Op = OCAT + blk_off(row0, (br ? 640 : 0) + head * 64, 1024);
        attn_unit(lds, Qp, ZQW, KB + kvi * NKEY * 64, VT + kvi * 64 * NKEY, Op, 1024, lat0, lat1, band, q0, use_sink ? sink[head] * LOG2E : 0.f, use_sink, br ? qn_c : qn_a, br ? kn_c : kn_a, cosT, qpos0, nact, tid, wave, lane);
    }
}

#define XB_TMO      128
#define XB_XCNT(j)  (256  + 64 * (j))
#define XB_XSUB(j)  (1280 + 64 * (j))
#define XB_XGEN(j)  (2304 + 64 * (j))
#define XB_TOP      3328
#define XB_TOPGEN   3392
#define XCD_BAR_WORDS 3456
#define XB_SPIN_CAP (1u << 18)
__device__ __forceinline__ unsigned xb_ld(unsigned* p)              { return __hip_atomic_load(p, __ATOMIC_RELAXED, __HIP_MEMORY_SCOPE_AGENT); }
__device__ __forceinline__ unsigned xb_add(unsigned* p, unsigned v) { return __hip_atomic_fetch_add(p, v, __ATOMIC_RELAXED, __HIP_MEMORY_SCOPE_AGENT); }
__device__ __forceinline__ unsigned xb_xcc_id() { return (unsigned)__builtin_amdgcn_s_getreg((3 << 11) | 20) & 0xFu; }
#define XB_SPIN(cond, bar) do { unsigned _sp = 0; while (cond) { __builtin_amdgcn_s_sleep(1); \
    if ((++_sp & 255u) == 0u) { if (xb_ld(&(bar)[XB_TMO])) break; if (_sp > XB_SPIN_CAP) { atomicAdd(&(bar)[XB_TMO], 1u); break; } } } } while (0)
struct XcdBarrier { unsigned* bar; unsigned x; volatile LAS unsigned* st; };
__device__ __forceinline__ XcdBarrier xcd_barrier_post(unsigned* bar, volatile LAS unsigned* st) {
    XcdBarrier b; b.bar = bar; b.x = xb_xcc_id(); b.st = st;
    if (threadIdx.x == 0) (void)xb_add(&bar[XB_XCNT(b.x)], 1u);
    return b;
}
__device__ __forceinline__ void xcd_barrier_complete(unsigned* bar, unsigned x, unsigned& nloc, unsigned& nx) {
    const unsigned G = gridDim.x * gridDim.y * gridDim.z;
    unsigned sum, cnt, mine, sp = 0u;
    for (;;) {
        sum = 0u; cnt = 0u; mine = 0u;
#pragma unroll
        for (unsigned j = 0; j < 16; ++j) { const unsigned c = xb_ld(&bar[XB_XCNT(j)]); sum += c; cnt += (c > 0u) ? 1u : 0u; mine = (j == x) ? c : mine; }
        if (sum == G) break;
        __builtin_amdgcn_s_sleep(1);
        if ((++sp & 255u) == 0u) { if (xb_ld(&bar[XB_TMO])) break; if (sp > XB_SPIN_CAP) { atomicAdd(&bar[XB_TMO], 1u); break; } }
    }
    nloc = mine > 0u ? mine : 1u; nx = cnt > 0u ? cnt : 1u;
}
__device__ __forceinline__ void xcd_barrier(const XcdBarrier& b) {
    asm volatile("s_waitcnt vmcnt(0)" ::: "memory");
    __syncthreads();
    if (threadIdx.x == 0) {
        unsigned* bar = b.bar;
        __builtin_amdgcn_s_waitcnt(0);
        unsigned nloc = b.st[0], nx = b.st[1];
        if (nloc == 0u) { xcd_barrier_complete(bar, b.x, nloc, nx); b.st[0] = nloc; b.st[1] = nx; }
        const unsigned old = xb_add(&bar[XB_XSUB(b.x)], 1u);
        const unsigned gen = old / nloc;
        if (old + 1u == (gen + 1u) * nloc) {
            __builtin_amdgcn_fence(__ATOMIC_RELEASE, "agent");
            asm volatile("s_waitcnt vmcnt(0)" ::: "memory");
            const unsigned og = xb_add(&bar[XB_TOP], 1u);
            const unsigned tg = og / nx;
            if (og + 1u == (tg + 1u) * nx) xb_add(&bar[XB_TOPGEN], 1u);
            else XB_SPIN(xb_ld(&bar[XB_TOPGEN]) == tg, bar);
            __builtin_amdgcn_fence(__ATOMIC_ACQUIRE, "agent");
            xb_add(&bar[XB_XGEN(b.x)], 1u);
            asm volatile("s_waitcnt vmcnt(0)" ::: "memory");
        } else {
            XB_SPIN(xb_ld(&bar[XB_XGEN(b.x)]) == gen, bar);
            __builtin_amdgcn_fence(__ATOMIC_ACQUIRE, "agent");
            asm volatile("s_waitcnt vmcnt(0)" ::: "memory");
        }
    }
    __syncthreads();
}

__global__ void __launch_bounds__(NTHR, 2) fwd_kernel(Args a) {
    extern __shared__ __attribute__((aligned(16))) unsigned char lds_raw[];
    LAS unsigned char* lds = (LAS unsigned char*)lds_raw;
    cg::grid_group grid = cg::this_grid();
    int tid = threadIdx.x, lane = tid & 63, wave = __builtin_amdgcn_readfirstlane(tid >> 6);
#define FRESH() do { tid = threadIdx.x; asm volatile("" : "+v"(tid)); lane = tid & 63; wave = __builtin_amdgcn_readfirstlane(tid >> 6); } while (0)
    const int G = gridDim.x, bx = blockIdx.x;
    const int vcu = (G % 8 == 0) ? (bx % 8) * (G / 8) + bx / 8 : bx;
    const int NGW = G * NWAVES;
    unsigned char* ws = a.ws;
    const int lo = a.ph_lo, hi = a.ph_hi;
    volatile LAS unsigned* bst = (volatile LAS unsigned*)(lds + LDS_BYTES - 16);
    if (tid < 4) bst[tid] = 0u;
    __syncthreads();
    XcdBarrier bar; bar.bar = (unsigned*)ws; bar.x = 0; bar.st = bst;
    if (hi - lo > 1) bar = xcd_barrier_post((unsigned*)ws, bst);
#ifndef PHMASK
#define PHMASK 0x7ffff
#endif
#define IN(k) (((PHMASK >> ((k) > 9 ? (k) - 9 : (k))) & 1) && lo <= (k) && (k) < hi)
#ifndef DUPMASK
#define DUPMASK 0
#endif
#define NREP(k) (((DUPMASK >> ((k) > 9 ? (k) - 9 : (k))) & 1) ? 2 : 1)
#define SEAM(k) do { if (hi - lo > 1) { if (hi == 0x7fffffff) grid.sync();   xcd_barrier(bar); } } while (0)

    float* mod = (float*)(ws + WS_MOD);
    float* XC = (float*)(ws + WS_XC);
    bf16* B1 = (bf16*)(ws + WS_B1); bf16* ZQ = (bf16*)(ws + WS_ZQ); bf16* Gt = (bf16*)(ws + WS_G); bf16* Y = ZQ; bf16* A1 = ZQ;

    if (IN(0)) for (int rep = 0; rep < NREP(0); ++rep) { FRESH(); phase_prologue(a, lds, tid, wave, lane, G); }
    SEAM(0);
    const float* BIAS1 = (const float*)(ws + WS_BIAS1); const float* BIAS2 = (const float*)(ws + WS_BIAS2);
    const float* AVb = (const float*)(ws + WS_AV); float* RSS = (float*)(ws + WS_RSS);
#pragma unroll 1
    for (int l = 0; l < 2; ++l) {
        const int P = 1 + 9 * l;
        const bool last = l == 1;
        const float* modl = mod + (size_t)l * 33 * 6144;
        unsigned char* wl = ws + WS_W + l * WL_SIZE;
        const float* xlat = l == 0 ? a.in[0] : a.out; const float* xctx = l == 0 ? a.in[2] : XC;
        const int nMall = last ? 256 : 288;
        if (l == 0) {
            if (IN(P + 0)) {
                if (bx < 50) { const int job = bx < 18 ? 0 : (bx < 34 ? 1 : 2); const int nN = job == 0 ? 18 : 16; const int c = job == 0 ? bx : (job == 1 ? bx - 18 : bx - 34);
                    const bf16* Ash = (const bf16*)(ws + WS_SH) + (size_t)job * 256 * 1024;
                    const bf16* Bw = job == 0 ? (const bf16*)(ws + WS_W + 1 * WL_SIZE + WL_IN) : (const bf16*)(ws + WS_W + (job - 1) * WL_SIZE + WL_W1);
                    float* outp = job == 0 ? (float*)(ws + WS_BIAS1) : (float*)(ws + WS_BIAS2) + (size_t)(job - 1) * 33 * FF;
                    pg8::Order S; S.init(1, nN, 0, 0, 1, 16, nN, c); pg8::EpiBias E{outp, job == 0 ? INW : FF};
                    pg8::gemm_phase(lds, Ash, 1024, Bw, 1024, S, E); }
                FRESH(); phase_norm(xlat, xctx, a.in[6] + l * 1024, modl, 0, 1, B1, TT, vcu * NWAVES + wave, NGW, lane);
            }
            SEAM(P + 0);
        }
        if (IN(P + 1)) { pg8::Order S; S.init(256, 18, 32, last ? 2 : 18, 1, 16, G, bx); pg8::EpiInProj E{ZQ, Gt, RSS + (size_t)1 * TT, BIAS1, l};
            pg8::gemm_phase(lds, B1, 1024, (const bf16*)(wl + WL_IN), 1024, S, E); }
        SEAM(P + 1);
        if (IN(P + 2)) { FRESH(); phase_qkvpool(a, l, lds, tid, wave, lane, vcu, G); }
        SEAM(P + 2);
        if (IN(P + 3)) { FRESH(); phase_attn(a, l, lds, tid, wave, lane, vcu, G); }
        SEAM(P + 3);
        if (IN(P + 4)) { pg8::Order S; S.init(nMall, 4, 0, 0, 1, 16, G, bx); pg8::EpiMerge E{Gt, Y};
            pg8::gemm_phase(lds, B1, 1024, (const bf16*)(wl + WL_BR), 1024, S, E); }
        SEAM(P + 4);
        if (IN(P + 5)) { pg8::Order S; S.init(nMall, 4, 0, 0, 1, 16, G, bx);
            pg8::EpiResid E{xlat, xctx, a.out, XC, modl, 2, B1, AVb + (size_t)(l * 2 + 1) * 33 * 1024, RSS + (size_t)(l == 0 ? 0 : 2) * TT};
            pg8::gemm_phase(lds, Y, 1024, (const bf16*)(wl + WL_WO), 1024, S, E); }
        SEAM(P + 5);
        if (IN(P + 7)) { pg8::Order S; S.init(nMall, 16, 0, 0, 1, 16, G, bx); pg8::EpiMlp1 E{A1, RSS + (size_t)(l == 0 ? 0 : 2) * TT, BIAS2 + (size_t)l * 33 * FF};
            pg8::gemm_phase(lds, B1, 1024, (const bf16*)(wl + WL_W1), 1024, S, E); }
        SEAM(P + 7);
        if (IN(P + 8)) { pg8::Order S; S.init(nMall, 4, 0, 0, 1, 64, G, bx);
            pg8::EpiResid E{a.out, XC, a.out, XC, modl, 5, last ? (bf16*)nullptr : B1, AVb + (size_t)(1 * 2 + 0) * 33 * 1024, RSS + (size_t)1 * TT};
            pg8::gemm_phase(lds, A1, FF, (const bf16*)(wl + WL_W2), FF, S, E); }
        if (!last) SEAM(P + 8);
    }
#undef IN
#undef SEAM
}

extern "C" void kernel_launch(void* const* d_in, const int* in_sizes, int n_in, void* d_out, int out_size, void* d_ws, size_t ws_size, hipStream_t stream) {
    static int grid = 0;
    if (grid == 0) {
        if (n_in != 22 || ws_size < WS_END) { fprintf(stderr, "kernel_launch: unexpected n_in %d / ws_size %zu (need %zu)\n", n_in, ws_size, (size_t)WS_END); grid = -1; return; }
        int dev = 0, cus = 0, per_cu = 0;
        hipGetDevice(&dev);
        hipDeviceGetAttribute(&cus, hipDeviceAttributeMultiprocessorCount, dev);
        if (hipFuncSetAttribute((const void*)fwd_kernel, hipFuncAttributeMaxDynamicSharedMemorySize, LDS_BYTES) != hipSuccess) { fprintf(stderr, "kernel_launch: hipFuncSetAttribute failed\n"); grid = -1; return; }
        hipOccupancyMaxActiveBlocksPerMultiprocessor(&per_cu, (const void*)fwd_kernel, NTHR, LDS_BYTES);
        (void)hipGetLastError();
        if (per_cu < 1) per_cu = 1;
        grid = cus;
        fprintf(stderr, "kernel_launch: cus %d per_cu %d grid %d ws %zu\n", cus, per_cu, grid, ws_size);
    }
    if (grid < 0) return;
    Args a{};
    for (int i = 0; i < 22; ++i) a.in[i] = (const float*)d_in[i];
    a.out = (float*)d_out; a.ws = (unsigned char*)d_ws;
#if ONE_LAUNCH
    if (hipMemsetAsync(d_ws, 0, XCD_BAR_WORDS * 4, stream) != hipSuccess) { fprintf(stderr, "memset failed\n"); return; }
    a.ph_lo = 0; a.ph_hi = 19;
    void* args[] = {&a};
    hipError_t e = hipLaunchCooperativeKernel((const void*)fwd_kernel, dim3(grid), dim3(NTHR), args, LDS_BYTES, stream);
    if (e != hipSuccess) fprintf(stderr, "cooperative launch failed: %s (grid %d)\n", hipGetErrorString(e), grid);
#else
    for (int ph = 0; ph < 19; ++ph) { a.ph_lo = ph; a.ph_hi = ph + 1; hipLaunchKernelGGL(fwd_kernel, dim3(grid), dim3(NTHR), LDS_BYTES, stream, a); }
#endif
}
```

```cpp
#include <hip/hip_runtime.h>
#include <hip/hip_cooperative_groups.h>
#include <cstdio>
namespace cg = cooperative_groups;

#define LAS __attribute__((address_space(3)))
typedef unsigned short bf16;
typedef short bf16x8 __attribute__((ext_vector_type(8)));
typedef float f32x4 __attribute__((ext_vector_type(4)));
typedef float f32x16 __attribute__((ext_vector_type(16)));
typedef unsigned u32x4 __attribute__((ext_vector_type(4)));
typedef unsigned u32x2 __attribute__((ext_vector_type(2)));

#ifndef ONE_LAUNCH
#define ONE_LAUNCH 1
#endif

constexpr int D = 1024, NB = 32, SEQ = 2048, CTXL = 256;
constexpr int TL = NB * SEQ, TC = NB * CTXL, TT = TL + TC;
constexpr int NKEY = CTXL + SEQ;
constexpr int ZQW = 1536, GWD = 3072, FF = 4096, INW = 4608;
constexpr int ZC_KA = 0, ZC_VA = 128, ZC_KC = 256, ZC_VC = 384, ZC_QA = 512, ZC_QC = 896, ZC_U = 1280;
constexpr float EPS = 1e-6f;
constexpr float LOG2E = 1.4426950408889634f;
constexpr float QSCALE = 0.125f * LOG2E;
constexpr int NTHR = 512, NWAVES = 8;
constexpr int LDS_BYTES = 147456;

constexpr size_t MiB = 1u << 20;
constexpr size_t WS_MOD = 1 * MiB;
constexpr size_t WS_ROPE = 3 * MiB;
constexpr size_t WS_W = 4 * MiB;
constexpr size_t WL_IN = 0, WL_W1 = 9 * MiB, WL_W2 = 17 * MiB, WL_WO = 25 * MiB, WL_BR = 27 * MiB, WL_SIZE = 29 * MiB;
constexpr size_t WS_XC = 62 * MiB;
constexpr size_t WS_B1 = 94 * MiB;
constexpr size_t WS_ZQ = 238 * MiB;
constexpr size_t WS_G = 454 * MiB;
constexpr size_t WS_K = 886 * MiB;
constexpr size_t WS_VT = 922 * MiB;
constexpr size_t WS_SH = 958 * MiB;
constexpr size_t WS_BIAS1 = 960 * MiB;
constexpr size_t WS_BIAS2 = 961 * MiB;
constexpr size_t WS_AV = 963 * MiB;
constexpr size_t WS_RSS = 964 * MiB;
constexpr size_t WS_END = 965 * MiB;

__device__ __forceinline__ unsigned cvt_pk_bf16(float lo, float hi) { unsigned r; asm volatile("v_cvt_pk_bf16_f32 %0, %1, %2" : "=v"(r) : "v"(lo), "v"(hi)); return r; }
__device__ __forceinline__ float bf_lo(unsigned u) { return __uint_as_float(u << 16); }
__device__ __forceinline__ float bf_hi(unsigned u) { return __uint_as_float(u & 0xffff0000u); }
__device__ __forceinline__ float wave_sum(float v) {
#pragma unroll
    for (int o = 1; o < 64; o <<= 1) v += __shfl_xor(v, o);
    return v;
}
__device__ __forceinline__ float fast_exp2(float x) { return __builtin_amdgcn_exp2f(x); }
__device__ __forceinline__ float sigmoidf_(float x) { return __builtin_amdgcn_rcpf(1.0f + fast_exp2(-x * LOG2E)); }

__device__ __forceinline__ size_t blk_off(int row, int col, int K) { return ((size_t)(row >> 8) * (size_t)(K >> 6) + (size_t)(col >> 6)) * 16384 + (size_t)(row & 255) * 64 + (size_t)(col & 63); }

namespace pg8 {
constexpr int BM = 256, BK = 64, HALF = 128, HTB = HALF * BK * 2, STAGE_BYTES = 8 * HTB;
__device__ __forceinline__ int lds_byte(int r, int c) { const int st = (r >> 4) * 2 + (c >> 5), rr = r & 15, cc = c & 31, ob = rr * 64 + cc * 2; return st * 1024 + (ob ^ (((ob >> 9) & 1) << 5)); }
__device__ __forceinline__ void stage_rc(int b, int& R, int& C) { const int st = b / 1024, sb = b % 1024, swz = sb ^ (((sb >> 9) & 1) << 5); R = (st >> 1) * 16 + swz / 64; C = (st & 1) * 32 + (swz % 64) / 2; }
__device__ __forceinline__ int perm32(int rho) { const int n = rho >> 4, i = rho & 15; return 8 * (i >> 2) + 4 * n + (i & 3); }

struct Unit { int pm, pn, k0, nt, tag; };

struct Order {
    int nM0, nN0, nM1, nN1, n0, ntot, G, c, nseg, ntfull;
    __device__ __forceinline__ void init(int nM0_, int nN0_, int nM1_, int nN1_, int nseg_, int ntfull_, int G_, int c_) {
        nM0 = nM0_; nN0 = nN0_; nM1 = nM1_; nN1 = nN1_; n0 = nM0 * nN0; ntot = n0 + nM1 * nN1; nseg = nseg_; ntfull = ntfull_; G = G_; c = c_; }
    static __device__ __forceinline__ void map(int L, int nM, int nN, int& pm, int& pn) {
        const int nwg = nM * nN; int wgid = L;
        { const int q = nwg / 8, r = nwg % 8, xcd = wgid % 8, off = wgid / 8; wgid = (xcd < r ? xcd * (q + 1) : r * (q + 1) + (xcd - r) * q) + off; }
        const int nig = 8 * nN, gid = wgid / nig, fm = gid * 8, gsz = (nM - fm) < 8 ? (nM - fm) : 8;
        pm = fm + ((wgid % nig) % gsz); pn = (wgid % nig) / gsz;
    }
    __device__ __forceinline__ bool next(int i, Unit& u) const {
        int ti = i, sg = 0;
        if (nseg == 3) { ti = i / 3; sg = i - 3 * ti; }
        const int L = ti * G + c; if (L >= ntot) return false;
        int pm, pn;
        if (L < n0) map(L, nM0, nN0, pm, pn); else { map(L - n0, nM1, nN1, pm, pn); pm += nM0; }
        u.pm = pm; u.pn = pn; u.tag = sg;
        if (nseg == 3) { u.k0 = sg == 0 ? 0 : (sg == 1 ? 384 : 640); u.nt = sg == 1 ? 4 : 6; } else { u.k0 = 0; u.nt = ntfull; }
        return true;
    }
};

template <class Epi>
__device__ __forceinline__ void gemm_phase(LAS unsigned char* lds, const bf16* A, int lda, const bf16* Bt, int ldb, const Order& S, const Epi& E) {
    int tid_ = threadIdx.x; asm volatile("" : "+v"(tid_));
    const int tid = tid_, wid = __builtin_amdgcn_readfirstlane(tid >> 6), lane = tid & 63, wr = wid >> 2, wc = wid & 3, fr = lane & 15, fq = lane >> 4;
    unsigned voffA[2], voffB[2];
#pragma unroll
    for (int i = 0; i < 2; ++i) { int R, C; stage_rc(tid * 16 + i * 8192, R, C); const int Rb = Epi::PERM ? ((R & ~31) + perm32(R & 31)) : R;
        voffA[i] = (unsigned)(R * 64 + C) * 2u; voffB[i] = (unsigned)(Rb * ldb + C) * 2u; }
    const size_t kstep = (size_t)(BK * 2), kstepA = 32768;
    const size_t hstepA = 16384, hstepB = (size_t)HALF * ldb * 2;
    const unsigned ldsw = (unsigned)wid * 1024u;
    const int aoff = lds_byte(wr * 64 + fr, fq * 8), boff = lds_byte(wc * 32 + fr, fq * 8);
#define PG8_SA(b, h) (((b) * 2 + (h)) * HTB)
#define PG8_SB(b, h) ((4 + (b) * 2 + (h)) * HTB)
#define PG8_STAGE(bufoff, gbase, voff) do { _Pragma("unroll") for (int _i = 0; _i < 2; ++_i) \
        __builtin_amdgcn_global_load_lds((const unsigned*)((const char*)(gbase) + (voff)[_i]), (LAS unsigned*)(lds + (bufoff) + ldsw + _i * 8192), 16, 0, 0); } while (0)
#define PG8_LDA(dst, b, h) do { _Pragma("unroll") for (int m = 0; m < 4; ++m) _Pragma("unroll") for (int k = 0; k < 2; ++k) dst[m][k] = *(const LAS bf16x8*)(lds + PG8_SA(b, h) + aoff + m * 2048 + k * 1024); } while (0)
#define PG8_LDB(dst, b, h) do { _Pragma("unroll") for (int n = 0; n < 2; ++n) _Pragma("unroll") for (int k = 0; k < 2; ++k) dst[n][k] = *(const LAS bf16x8*)(lds + PG8_SB(b, h) + boff + n * 2048 + k * 1024); } while (0)
#define PG8_MMA(ai, bj, At, Bt_) do { __builtin_amdgcn_s_setprio(1); _Pragma("unroll") for (int m = 0; m < 4; ++m) _Pragma("unroll") for (int n = 0; n < 2; ++n) _Pragma("unroll") for (int k = 0; k < 2; ++k) \
        acc[ai][bj][m][n] = __builtin_amdgcn_mfma_f32_16x16x32_bf16(Bt_[n][k], At[m][k], acc[ai][bj][m][n], 0, 0, 0); __builtin_amdgcn_s_setprio(0); } while (0)
#define PG8_WAIT_V(n) asm volatile("s_waitcnt vmcnt(" #n ")" ::: "memory")
#define PG8_WAIT_L(n) asm volatile("s_waitcnt lgkmcnt(" #n ")" ::: "memory")
#define PG8_BAR __builtin_amdgcn_s_barrier()
#define PG8_SCHED __builtin_amdgcn_sched_barrier(0)
    Unit cur, nxt; int ui = 0;
    if (!S.next(0, cur)) return;
    f32x4 acc[2][2][4][2];
#pragma unroll
    for (int a = 0; a < 2; ++a)
#pragma unroll
        for (int b = 0; b < 2; ++b)
#pragma unroll
            for (int m = 0; m < 4; ++m)
#pragma unroll
                for (int n = 0; n < 2; ++n) acc[a][b][m][n] = (f32x4){0.f, 0.f, 0.f, 0.f};
    bf16x8 At[4][2], B0[2][2], B1[2][2];
    const char* cA = (const char*)A + blk_off(cur.pm * 256, cur.k0, lda) * 2; const char* cB = (const char*)Bt + ((size_t)cur.pn * 256 * ldb + cur.k0) * 2;
    PG8_STAGE(PG8_SB(0, 0), cB, voffB); PG8_STAGE(PG8_SB(0, 1), cB + hstepB, voffB); PG8_STAGE(PG8_SA(0, 0), cA, voffA); PG8_STAGE(PG8_SA(0, 1), cA + hstepA, voffA);
    if (wr == 1) PG8_BAR;
    PG8_WAIT_V(2); PG8_BAR;
    PG8_STAGE(PG8_SB(1, 0), cB + kstep, voffB); PG8_STAGE(PG8_SA(1, 0), cA + kstepA, voffA); PG8_STAGE(PG8_SB(1, 1), cB + hstepB + kstep, voffB);
    PG8_WAIT_V(6); PG8_BAR;
    for (;;) {
        const bool has_next = S.next(ui + 1, nxt);
        const char* nA = has_next ? (const char*)A + blk_off(nxt.pm * 256, nxt.k0, lda) * 2 : cA; const char* nB = has_next ? (const char*)Bt + ((size_t)nxt.pn * 256 * ldb + nxt.k0) * 2 : cB;
        const int nt = cur.nt;
        for (int t = 0; t < nt; t += 2) {
            const bool last = (t == nt - 2);
            if constexpr (Epi::HOOK) { if (t == 6 || t == 10) E.mid(acc, cur, t == 6 ? 0 : 1, wr, wc, fr, fq); }
            const char* a1 = cA + (size_t)(t + 1) * kstepA;
            const char* a2 = last ? nA : cA + (size_t)(t + 2) * kstepA; const char* b2 = last ? nB : cB + (size_t)(t + 2) * kstep;
            const char* a3 = a2 + kstepA; const char* b3 = b2 + kstep;
            PG8_LDB(B0, 0, 0); PG8_LDB(B1, 0, 1); PG8_SCHED; PG8_LDA(At, 0, 0); PG8_STAGE(PG8_SA(1, 1), a1 + hstepA, voffA);
            PG8_WAIT_V(8); PG8_WAIT_L(0); PG8_BAR; PG8_MMA(0, 0, At, B0); PG8_MMA(0, 1, At, B1); PG8_BAR; PG8_SCHED;
            PG8_LDA(At, 0, 1); PG8_STAGE(PG8_SB(0, 0), b2, voffB); PG8_STAGE(PG8_SB(0, 1), b2 + hstepB, voffB); PG8_STAGE(PG8_SA(0, 0), a2, voffA);
            PG8_WAIT_V(8); PG8_WAIT_L(0); PG8_BAR; PG8_MMA(1, 0, At, B0); PG8_MMA(1, 1, At, B1); PG8_BAR; PG8_SCHED;
            PG8_LDB(B0, 1, 0); PG8_LDB(B1, 1, 1); PG8_SCHED; PG8_LDA(At, 1, 0); PG8_STAGE(PG8_SA(0, 1), a2 + hstepA, voffA);
            PG8_WAIT_V(8); PG8_WAIT_L(0); PG8_BAR; PG8_MMA(0, 0, At, B0); PG8_MMA(0, 1, At, B1); PG8_BAR; PG8_SCHED;
            PG8_LDA(At, 1, 1); PG8_STAGE(PG8_SB(1, 0), b3, voffB); PG8_STAGE(PG8_SB(1, 1), b3 + hstepB, voffB); PG8_STAGE(PG8_SA(1, 0), a3, voffA);
            PG8_WAIT_V(8); PG8_WAIT_L(0); PG8_BAR; PG8_MMA(1, 0, At, B0); PG8_MMA(1, 1, At, B1); PG8_BAR; PG8_SCHED;
        }
        if (wr == 0) PG8_BAR;
        E(acc, cur, wr, wc, fr, fq);
        if (!has_next) break;
#pragma unroll
        for (int a = 0; a < 2; ++a)
#pragma unroll
            for (int b = 0; b < 2; ++b)
#pragma unroll
                for (int m = 0; m < 4; ++m)
#pragma unroll
                    for (int n = 0; n < 2; ++n) acc[a][b][m][n] = (f32x4){0.f, 0.f, 0.f, 0.f};
        cur = nxt; cA = nA; cB = nB; ++ui;
        if (wr == 1) PG8_BAR;
    }
    PG8_WAIT_V(0);
    PG8_BAR;
#undef PG8_SA
#undef PG8_SB
#undef PG8_STAGE
#undef PG8_LDA
#undef PG8_LDB
#undef PG8_MMA
#undef PG8_WAIT_V
#undef PG8_WAIT_L
#undef PG8_BAR
#undef PG8_SCHED
}

struct EpiInProj {
    static constexpr bool PERM = true, HOOK = false;
    bf16* ZQ; bf16* G; const float* rss; const float* bias; int fused;
    __device__ __forceinline__ void operator()(const f32x4 (&acc)[2][2][4][2], const Unit& u, int wr, int wc, int fr, int fq) const {
        const int row0 = u.pm * 256 + wr * 64 + fr;
        const bool gate = u.pn >= 6;
        bf16* base = gate ? G : ZQ; const int ld = gate ? GWD : ZQW; const int col0 = (gate ? (u.pn - 6) * 256 : u.pn * 256) + wc * 32 + 8 * fq;
        f32x4 bv[2][2];
#pragma unroll
        for (int bj = 0; bj < 2; ++bj) { bv[bj][0] = (f32x4){0.f, 0.f, 0.f, 0.f}; bv[bj][1] = bv[bj][0]; }
        if (fused) { const int r = u.pm >= 256 ? 32 : (u.pm >> 3); const float* bp = bias + (size_t)r * INW + u.pn * 256 + wc * 32 + 8 * fq;
#pragma unroll
            for (int bj = 0; bj < 2; ++bj) { bv[bj][0] = *(const f32x4*)(bp + bj * 128); bv[bj][1] = *(const f32x4*)(bp + bj * 128 + 4); } }
        const float gsc = gate ? -LOG2E : 1.0f;
#pragma unroll
        for (int bj = 0; bj < 2; ++bj) { bv[bj][0] *= gsc; bv[bj][1] *= gsc; }
        float rsv[8];
#pragma unroll
        for (int q = 0; q < 8; ++q) rsv[q] = 1.0f;
        if (fused) {
#pragma unroll
            for (int q = 0; q < 8; ++q) rsv[q] = rss[row0 + (q >> 2) * 128 + (q & 3) * 16];
#pragma unroll
            for (int q = 0; q < 8; ++q) rsv[q] = rsqrtf(rsv[q] * (1.0f / 1024.0f) + EPS); }
#pragma unroll
        for (int ai = 0; ai < 2; ++ai)
#pragma unroll
            for (int m = 0; m < 4; ++m) { bf16* rowp = base + (size_t)(row0 + ai * 128 + m * 16) * ld + col0;
                const float rs = rsv[ai * 4 + m];
#pragma unroll
                for (int bj = 0; bj < 2; ++bj) { f32x4 v0 = acc[ai][bj][m][0] * (rs * gsc) + bv[bj][0], v1 = acc[ai][bj][m][1] * (rs * gsc) + bv[bj][1];
                    if (gate) {
#pragma unroll
                        for (int j = 0; j < 4; ++j) { v0[j] = __builtin_amdgcn_rcpf(1.0f + fast_exp2(__builtin_amdgcn_fmed3f(v0[j], -99.f, 99.f))); v1[j] = __builtin_amdgcn_rcpf(1.0f + fast_exp2(__builtin_amdgcn_fmed3f(v1[j], -99.f, 99.f)));     } }
                    u32x4 w; w.x = cvt_pk_bf16(v0[0], v0[1]); w.y = cvt_pk_bf16(v0[2], v0[3]); w.z = cvt_pk_bf16(v1[0], v1[1]); w.w = cvt_pk_bf16(v1[2], v1[3]);
                    *(u32x4*)(rowp + bj * 128) = w; } }
    }
};
struct EpiMerge {
    static constexpr bool PERM = true, HOOK = true;
    const bf16* G; bf16* Y;
    __device__ __forceinline__ void mid(f32x4 (&acc)[2][2][4][2], const Unit& u, int which, int wr, int wc, int fr, int fq) const {
        const int row0 = u.pm * 256 + wr * 64 + fr, col0 = u.pn * 256 + wc * 32 + 8 * fq;
        const bf16* gp = G + (size_t)row0 * GWD + which * 1024 + col0;
#pragma unroll
        for (int ai = 0; ai < 2; ++ai) {
            asm volatile("" : "+v"(gp));
            u32x4 gnv[4][2], gdv[4][2];
#pragma unroll
            for (int m = 0; m < 4; ++m)
#pragma unroll
                for (int bj = 0; bj < 2; ++bj) { gnv[m][bj] = *(const u32x4*)(gp + (size_t)m * 16 * GWD + bj * 128); gdv[m][bj] = *(const u32x4*)(gp + (size_t)m * 16 * GWD + 1024 + bj * 128); }
            __builtin_amdgcn_sched_barrier(0);
#pragma unroll
            for (int m = 0; m < 4; ++m)
#pragma unroll
                for (int bj = 0; bj < 2; ++bj) { const u32x4 gn = gnv[m][bj], gd = gdv[m][bj];
                    f32x4& v0 = acc[ai][bj][m][0]; f32x4& v1 = acc[ai][bj][m][1];
                    v0[0] *= bf_lo(gn.x) * __builtin_amdgcn_rcpf(bf_lo(gd.x)); v0[1] *= bf_hi(gn.x) * __builtin_amdgcn_rcpf(bf_hi(gd.x));
                    v0[2] *= bf_lo(gn.y) * __builtin_amdgcn_rcpf(bf_lo(gd.y)); v0[3] *= bf_hi(gn.y) * __builtin_amdgcn_rcpf(bf_hi(gd.y));
                    v1[0] *= bf_lo(gn.z) * __builtin_amdgcn_rcpf(bf_lo(gd.z)); v1[1] *= bf_hi(gn.z) * __builtin_amdgcn_rcpf(bf_hi(gd.z));
                    v1[2] *= bf_lo(gn.w) * __builtin_amdgcn_rcpf(bf_lo(gd.w)); v1[3] *= bf_hi(gn.w) * __builtin_amdgcn_rcpf(bf_hi(gd.w)); }
            asm volatile("" ::: "memory");
            gp += (size_t)128 * GWD;
        }
    }
    __device__ __forceinline__ void operator()(const f32x4 (&acc)[2][2][4][2], const Unit& u, int wr, int wc, int fr, int fq) const {
        const int row0 = u.pm * 256 + wr * 64 + fr, col0 = u.pn * 256 + wc * 32 + 8 * fq;
        const bf16* __restrict__ Gp = G; bf16* __restrict__ Yp = Y;
#pragma unroll
        for (int ai = 0; ai < 2; ++ai) {
            u32x4 gr[4][2];
#pragma unroll
            for (int m = 0; m < 4; ++m)
#pragma unroll
                for (int bj = 0; bj < 2; ++bj) gr[m][bj] = *(const u32x4*)(Gp + (size_t)(row0 + ai * 128 + m * 16) * GWD + 2 * 1024 + col0 + bj * 128);
#pragma unroll
            for (int m = 0; m < 4; ++m) { const size_t row = (size_t)(row0 + ai * 128 + m * 16);
#pragma unroll
                for (int bj = 0; bj < 2; ++bj) { const int col = col0 + bj * 128;
                    const u32x4 g = gr[m][bj];
                    const f32x4 v0 = acc[ai][bj][m][0], v1 = acc[ai][bj][m][1];
                    u32x4 w;
                    w.x = cvt_pk_bf16(bf_lo(g.x) * v0[0], bf_hi(g.x) * v0[1]);
                    w.y = cvt_pk_bf16(bf_lo(g.y) * v0[2], bf_hi(g.y) * v0[3]);
                    w.z = cvt_pk_bf16(bf_lo(g.z) * v1[0], bf_hi(g.z) * v1[1]);
                    w.w = cvt_pk_bf16(bf_lo(g.w) * v1[2], bf_hi(g.w) * v1[3]);
                    *(u32x4*)(Yp + blk_off((int)row, col, 1024)) = w; } } }
    }
};
struct EpiResid {
    static constexpr bool PERM = false, HOOK = false;
    const float* src_lat; const float* src_ctx; float* dst_lat; float* dst_ctx; const float* modl; int gidx;
    bf16* XA; const float* av; float* rowss;
    __device__ __forceinline__ void operator()(const f32x4 (&acc)[2][2][4][2], const Unit& u, int wr, int wc, int fr, int fq) const {
        const bool isctx = u.pm >= 256; const int r = isctx ? 32 : (u.pm >> 3);
        const int row0 = (isctx ? (u.pm - 256) * 256 : u.pm * 256) + wr * 64 + fr, col0 = u.pn * 256 + wc * 32 + 4 * fq;
        const int grow0 = u.pm * 256 + wr * 64 + fr;
        const float* __restrict__ src = isctx ? src_ctx : src_lat; float* __restrict__ dst = isctx ? dst_ctx : dst_lat;
        bf16* __restrict__ XAp = XA; float* __restrict__ rsp = rowss;
        const bool fuse = XA != nullptr;
        f32x4 gv[2][2], avv[2][2];
#pragma unroll
        for (int bj = 0; bj < 2; ++bj)
#pragma unroll
            for (int n = 0; n < 2; ++n) { gv[bj][n] = *(const f32x4*)(modl + (size_t)r * 6144 + gidx * 1024 + col0 + bj * 128 + n * 16);
                avv[bj][n] = (f32x4){0.f, 0.f, 0.f, 0.f}; if (fuse) avv[bj][n] = *(const f32x4*)(av + (size_t)r * 1024 + col0 + bj * 128 + n * 16); }
#pragma unroll
        for (int ai = 0; ai < 2; ++ai)
#pragma unroll
        for (int mh = 0; mh < 2; ++mh) {
            f32x4 xr[2][2][2];
#pragma unroll
            for (int mm = 0; mm < 2; ++mm)
#pragma unroll
                for (int bj = 0; bj < 2; ++bj)
#pragma unroll
                    for (int n = 0; n < 2; ++n) xr[mm][bj][n] = *(const f32x4*)(src + (size_t)(row0 + ai * 128 + (2 * mh + mm) * 16) * 1024 + col0 + bj * 128 + n * 16);
#pragma unroll
            for (int mm = 0; mm < 2; ++mm) { const int m = 2 * mh + mm; const size_t off = (size_t)(row0 + ai * 128 + m * 16) * 1024 + col0; const int grow = grow0 + ai * 128 + m * 16;
                float ss = 0.f;
#pragma unroll
                for (int bj = 0; bj < 2; ++bj)
#pragma unroll
                    for (int n = 0; n < 2; ++n) { const f32x4 y = xr[mm][bj][n] + gv[bj][n] * acc[ai][bj][m][n];
                        *(f32x4*)(dst + off + bj * 128 + n * 16) = y;
                        if (fuse) { ss += (y.x * y.x + y.y * y.y) + (y.z * y.z + y.w * y.w); const f32x4 h = y * avv[bj][n];
                            u32x2 w; w.x = cvt_pk_bf16(h.x, h.y); w.y = cvt_pk_bf16(h.z, h.w); *(u32x2*)(XAp + blk_off(grow, col0 + bj * 128 + n * 16, 1024)) = w; } }
                if (fuse) { ss += __shfl_xor(ss, 16); ss += __shfl_xor(ss, 32); if (fq == 0) atomicAdd(rsp + grow, ss); } }
        }
    }
};
struct EpiMlp1 {
    static constexpr bool PERM = true, HOOK = false;
    bf16* A1; const float* rss; const float* bias;
    __device__ __forceinline__ void operator()(const f32x4 (&acc)[2][2][4][2], const Unit& u, int wr, int wc, int fr, int fq) const {
        const int row0 = u.pm * 256 + wr * 64 + fr, col0 = u.pn * 256 + wc * 32 + 8 * fq;
        const int r = u.pm >= 256 ? 32 : (u.pm >> 3);
        f32x4 bv[2][2];
#pragma unroll
        for (int bj = 0; bj < 2; ++bj) { bv[bj][0] = *(const f32x4*)(bias + (size_t)r * FF + col0 + bj * 128); bv[bj][1] = *(const f32x4*)(bias + (size_t)r * FF + col0 + bj * 128 + 4); }
        float rsv[8];
#pragma unroll
        for (int q = 0; q < 8; ++q) rsv[q] = rss[row0 + (q >> 2) * 128 + (q & 3) * 16];
#pragma unroll
        for (int q = 0; q < 8; ++q) rsv[q] = rsqrtf(rsv[q] * (1.0f / 1024.0f) + EPS);
#pragma unroll
        for (int ai = 0; ai < 2; ++ai)
#pragma unroll
            for (int m = 0; m < 4; ++m) { bf16* rowp = A1 + blk_off(row0 + ai * 128 + m * 16, col0, FF);
                const float rs = rsv[ai * 4 + m];
#pragma unroll
                for (int bj = 0; bj < 2; ++bj) { f32x4 v0 = acc[ai][bj][m][0] * rs + bv[bj][0], v1 = acc[ai][bj][m][1] * rs + bv[bj][1];
#pragma unroll
                    for (int j = 0; j < 4; ++j) { const float a = fmaxf(v0[j], 0.f), b = fmaxf(v1[j], 0.f); v0[j] = a * a; v1[j] = b * b; }
                    u32x4 w; w.x = cvt_pk_bf16(v0[0], v0[1]); w.y = cvt_pk_bf16(v0[2], v0[3]); w.z = cvt_pk_bf16(v1[0], v1[1]); w.w = cvt_pk_bf16(v1[2], v1[3]);
                    *(u32x4*)(rowp + bj * 2 * 16384) = w; } }
    }
};
struct EpiBias {
    static constexpr bool PERM = true, HOOK = false;
    float* out; int ldo;
    __device__ __forceinline__ void operator()(const f32x4 (&acc)[2][2][4][2], const Unit& u, int wr, int wc, int fr, int fq) const {
        const int col0 = u.pn * 256 + wc * 32 + 8 * fq;
        if (wr == 0) {
#pragma unroll
            for (int m = 0; m < 3; ++m) { const int row = m * 16 + fr;
                if (row < 33) {
#pragma unroll
                    for (int bj = 0; bj < 2; ++bj) { *(f32x4*)(out + (size_t)row * ldo + col0 + bj * 128) = acc[0][bj][m][0]; *(f32x4*)(out + (size_t)row * ldo + col0 + bj * 128 + 4) = acc[0][bj][m][1]; } } }
        }
    }
};
}

struct Args {
    const float* in[22];
    float* out; unsigned char* ws;
    int ph_lo, ph_hi;
};

__device__ __forceinline__ void transpose_item(const float* W, int ldw, bf16* WT, int ldwt, int kofs, int k0, int nsrc0, int ndst0, LAS float* scr, int lane) {
#pragma unroll 8
    for (int i = 0; i < 32; ++i) { const int kk = 2 * i + (lane >> 5); scr[kk * 33 + (lane & 31)] = W[(size_t)(k0 + kk) * ldw + nsrc0 + (lane & 31)]; }
    asm volatile("s_waitcnt lgkmcnt(0)" ::: "memory");
    const int c = lane & 7;
#pragma unroll
    for (int j = 0; j < 4; ++j) { const int n = (lane >> 3) + 8 * j; const LAS float* s = scr + (8 * c) * 33 + n;
        u32x4 o; o.x = cvt_pk_bf16(s[0 * 33], s[1 * 33]); o.y = cvt_pk_bf16(s[2 * 33], s[3 * 33]); o.z = cvt_pk_bf16(s[4 * 33], s[5 * 33]); o.w = cvt_pk_bf16(s[6 * 33], s[7 * 33]);
        *(u32x4*)(WT + (size_t)(ndst0 + n) * ldwt + kofs + k0 + 8 * c) = o; }
    asm volatile("s_waitcnt lgkmcnt(0)" ::: "memory");
}
__device__ __forceinline__ int inproj_src_col(int n) {
    if (n < 128) return 384 + n;
    if (n < 256) return 512 + (n - 128);
    if (n < 384) return 1024 + (n - 256);
    if (n < 512) return 1152 + (n - 384);
    if (n < 896) return n - 512;
    if (n < 1280) return 640 + (n - 896);
    return n;
}
__device__ __forceinline__ void sincos_d(double a, float& s, float& c) {
    const double twopi = 6.283185307179586476925286766559;
    const double k = __builtin_rint(a / twopi);
    double r = a - k * twopi;
    r *= 0.25;
    const double r2 = r * r;
    double sn = r * (1.0 + r2 * (-1.0 / 6 + r2 * (1.0 / 120 + r2 * (-1.0 / 5040 + r2 * (1.0 / 362880 + r2 * (-1.0 / 39916800 + r2 * (1.0 / 6227020800.0)))))));
    double cs = 1.0 + r2 * (-0.5 + r2 * (1.0 / 24 + r2 * (-1.0 / 720 + r2 * (1.0 / 40320 + r2 * (-1.0 / 3628800 + r2 * (1.0 / 479001600.0 + r2 * (-1.0 / 87178291200.0)))))));
#pragma unroll
    for (int i = 0; i < 2; ++i) { const double s2 = 2.0 * sn * cs, c2 = cs * cs - sn * sn; sn = s2; cs = c2; }
    s = (float)sn; c = (float)cs;
}

__device__ __forceinline__ void phase_prologue(const Args& a, LAS unsigned char* lds, int tid, int wave, int lane, int G) {
    unsigned char* ws = a.ws;
    const int bx = blockIdx.x;
    if (bx < 192) {
        LAS float* silu = (LAS float*)lds;
        LAS float* red = (LAS float*)(lds + 33 * 1024 * 4);
        const float* cin = a.in[1]; const float* cctx = a.in[3];
        for (int i = tid; i < 33 * 1024; i += NTHR) { const float v = i < 32 * 1024 ? cin[i] : cctx[i - 32 * 1024]; silu[i] = v * __builtin_amdgcn_rcpf(1.0f + __expf(-v)); }
        __syncthreads();
        const int l = bx / 96, colblk = bx % 96;
        const float* wa = a.in[4] + (size_t)l * 1024 * 6144; const float* ba = a.in[5] + (size_t)l * 6144;
        float* modl = (float*)(ws + WS_MOD) + (size_t)l * 33 * 6144;
        float acc[33];
#pragma unroll
        for (int r = 0; r < 33; ++r) acc[r] = 0.f;
        const float* wp = wa + (size_t)(wave * 128) * 6144 + colblk * 64 + lane;
        for (int k = 0; k < 128; k += 4) {
            const float w0 = wp[(size_t)(k + 0) * 6144], w1 = wp[(size_t)(k + 1) * 6144], w2 = wp[(size_t)(k + 2) * 6144], w3 = wp[(size_t)(k + 3) * 6144];
#pragma unroll
            for (int r = 0; r < 33; ++r) { const f32x4 s = *(const LAS f32x4*)(silu + r * 1024 + wave * 128 + k); acc[r] += s.x * w0 + s.y * w1 + s.z * w2 + s.w * w3; }
        }
        for (int w = 0; w < 8; ++w) {
            if (wave == w) {
#pragma unroll
                for (int r = 0; r < 33; ++r) { if (w == 0) red[r * 64 + lane] = acc[r]; else red[r * 64 + lane] += acc[r]; } }
            __syncthreads();
        }
        { const int vidx = colblk >> 4;
          float* AVb = (float*)(ws + WS_AV); bf16* SHb = (bf16*)(ws + WS_SH);
          for (int i = tid; i < 33 * 64; i += NTHR) { const int r = i >> 6, cc = i & 63; const int col = (colblk & 15) * 64 + cc;
            const float val = red[i] + ba[colblk * 64 + cc];
            modl[(size_t)r * 6144 + colblk * 64 + cc] = val;
            if (vidx == 1) AVb[((size_t)(l * 2 + 0) * 33 + r) * 1024 + col] = a.in[6][l * 1024 + col] * (1.0f + val);
            if (vidx == 4) AVb[((size_t)(l * 2 + 1) * 33 + r) * 1024 + col] = a.in[7][l * 1024 + col] * (1.0f + val);
            if (vidx == 0 && l == 1) SHb[blk_off(r, col, 1024)] = (bf16)(cvt_pk_bf16(val, 0.f) & 0xffffu);
            if (vidx == 3) SHb[(size_t)(1 + l) * 256 * 1024 + blk_off(r, col, 1024)] = (bf16)(cvt_pk_bf16(val, 0.f) & 0xffffu); } }
        __syncthreads();
    } else {
        LAS float* wps = (LAS float*)lds;
        for (int it = bx - 192; it < 128; it += 64) {
            const int l = it >> 6, g = (it >> 4) & 3, nb = it & 15;
            const float* wpool = a.in[14] + ((size_t)l * 4 + g) * 4096; const float* ps = a.in[15] + (size_t)l * 256 + g * 64;
            const float* wbb = a.in[17] + (size_t)l * 256 * 1024 + (size_t)(g * 64) * 1024 + nb * 64;
            bf16* WbrT = (bf16*)(ws + WS_W + l * WL_SIZE + WL_BR);
            for (int i = tid; i < 4096; i += NTHR) wps[i] = wpool[i] * ps[i & 63];
            __syncthreads();
            float acc[8];
#pragma unroll
            for (int ci = 0; ci < 8; ++ci) acc[ci] = 0.f;
            for (int d = 0; d < 64; ++d) { const float b = wbb[(size_t)d * 1024 + lane];
#pragma unroll
                for (int ci = 0; ci < 8; ++ci) acc[ci] += wps[(wave * 8 + ci) * 64 + d] * b; }
            u32x4 o; o.x = cvt_pk_bf16(acc[0], acc[1]); o.y = cvt_pk_bf16(acc[2], acc[3]); o.z = cvt_pk_bf16(acc[4], acc[5]); o.w = cvt_pk_bf16(acc[6], acc[7]);
            *(u32x4*)(WbrT + (size_t)(nb * 64 + lane) * 1024 + 384 + g * 64 + wave * 8) = o;
            __syncthreads();
        }
    }
    { float* rssb = (float*)(ws + WS_RSS); for (int i = bx * NTHR + tid; i < 3 * TT; i += G * NTHR) rssb[i] = 0.f; }
    {
        float* cs = (float*)(ws + WS_ROPE); float* sn = cs + 2048 * 32;
        for (int i = bx * NTHR + tid; i < 2048 * 32; i += G * NTHR) {
            const int t = i >> 5, j = i & 31; const int jj = j & 15;
            const float inv = 1.0f / powf(10000.0f, (float)(2 * jj) / 32.0f);
            const float pos = (float)(j < 16 ? (t >> 6) : (t & 63));
            const float ang = pos * inv;
            float s, c; sincos_d((double)ang, s, c); cs[i] = c; sn[i] = s;
        }
    }
    {
        LAS float* scr = (LAS float*)(lds + wave * 16384);
        const int gw = bx * NWAVES + wave, NGW = G * NWAVES;
        for (int it = gw; it < 2 * 7296; it += NGW) {
            const int l = it / 7296; int r = it - l * 7296;
            unsigned char* wl = ws + WS_W + l * WL_SIZE;
            if (r < 2304) { const int kb = r / 144, nb = r % 144; transpose_item(a.in[8] + (size_t)l * 1024 * INW, INW, (bf16*)(wl + WL_IN), 1024, 0, kb * 64, inproj_src_col(nb * 32), nb * 32, scr, lane); continue; } r -= 2304;
            if (r < 2048) { const int kb = r / 128, nb = r % 128; transpose_item(a.in[20] + (size_t)l * 1024 * FF, FF, (bf16*)(wl + WL_W1), 1024, 0, kb * 64, nb * 32, nb * 32, scr, lane); continue; } r -= 2048;
            if (r < 2048) { const int kb = r / 32, nb = r % 32; transpose_item(a.in[21] + (size_t)l * FF * 1024, 1024, (bf16*)(wl + WL_W2), FF, 0, kb * 64, nb * 32, nb * 32, scr, lane); continue; } r -= 2048;
            if (r < 512) { const int kb = r / 32, nb = r % 32; transpose_item(a.in[19] + (size_t)l * 1024 * 1024, 1024, (bf16*)(wl + WL_WO), 1024, 0, kb * 64, nb * 32, nb * 32, scr, lane); continue; } r -= 512;
            if (r < 192) { const int kb = r / 32, nb = r % 32; transpose_item(a.in[16] + (size_t)l * 384 * 1024, 1024, (bf16*)(wl + WL_BR), 1024, 0, kb * 64, nb * 32, nb * 32, scr, lane); continue; } r -= 192;
            { const int kb = r / 32, nb = r % 32; transpose_item(a.in[18] + (size_t)l * 384 * 1024, 1024, (bf16*)(wl + WL_BR), 1024, 640, kb * 64, nb * 32, nb * 32, scr, lane); }
        }
    }
}

__device__ __forceinline__ void phase_norm(const float* src_lat, const float* src_ctx, const float* normw, const float* modl, int sh_idx, int sc_idx, bf16* H, int nrows, int gw, int NGW, int lane) {
    for (int row = gw; row < nrows; row += NGW) {
        const bool isctx = row >= TL; const int r = isctx ? 32 : (row >> 11);
        const float* xr = isctx ? src_ctx + (size_t)(row - TL) * 1024 : src_lat + (size_t)row * 1024;
        const f32x4* xp = (const f32x4*)xr + lane;
        f32x4 v[4]; float ss = 0.f;
#pragma unroll
        for (int j = 0; j < 4; ++j) { v[j] = xp[64 * j]; ss += (v[j].x * v[j].x + v[j].y * v[j].y) + (v[j].z * v[j].z + v[j].w * v[j].w); }
        const float rstd = rsqrtf(wave_sum(ss) * (1.0f / 1024.0f) + EPS);
        const f32x4* wp = (const f32x4*)normw + lane; const f32x4* scp = (const f32x4*)(modl + (size_t)r * 6144 + sc_idx * 1024) + lane; const f32x4* shp = (const f32x4*)(modl + (size_t)r * 6144 + sh_idx * 1024) + lane;
#pragma unroll
        for (int j = 0; j < 4; ++j) { const f32x4 w = wp[64 * j], sc = scp[64 * j], sh = shp[64 * j];
            const f32x4 h = (v[j] * rstd) * w * (sc + 1.0f) + sh;
            *(unsigned long long*)(H + blk_off(row, 4 * (lane + 64 * j), 1024)) = (unsigned long long)cvt_pk_bf16(h.x, h.y) | ((unsigned long long)cvt_pk_bf16(h.z, h.w) << 32); }
    }
}

__device__ __forceinline__ void phase_qkvpool(const Args& a, int layer, LAS unsigned char* lds, int tid, int wave, int lane, int vcu, int G) {
    unsigned char* ws = a.ws;
    const bf16* ZQ = (const bf16*)(ws + WS_ZQ); bf16* OCAT = (bf16*)(ws + WS_B1); bf16* KB = (bf16*)(ws + WS_K); bf16* VT = (bf16*)(ws + WS_VT);
    const float* cosT = (const float*)(ws + WS_ROPE); const float* sinT = cosT + 2048 * 32;
    const float* kn_a = a.in[10] + layer * 64; const float* kn_c = a.in[12] + layer * 64;
    LAS bf16* Vs = (LAS bf16*)lds;
    LAS bf16* Us = (LAS bf16*)(lds + 64 * 264 * 2);
    const bool last = layer == 1;
    const int tk0 = tid >> 4, hs = (tid >> 2) & 3, qd = tid & 3;
    const int kcol = (hs < 2 ? ZC_KA + hs * 64 : ZC_KC + (hs - 2) * 64) + qd * 16;
    const int kbr = hs >> 1, khk = hs & 1;
    f32x4 gq[4];
    { const float* gwp = hs < 2 ? kn_a : kn_c;
#pragma unroll
      for (int j = 0; j < 4; ++j) gq[j] = *(const f32x4*)(gwp + qd * 16 + 4 * j); }
    for (int ch = vcu; ch < TT / 64; ch += G) {
        const int row0 = ch * 64; const bool isctx = row0 >= TL;
        const int b = isctx ? (row0 - TL) / CTXL : row0 / SEQ;
        const int t0 = isctx ? (row0 - TL) % CTXL : row0 % SEQ;
        const int nseq = isctx ? CTXL : SEQ; const int seqrow0 = row0 - t0;
        const int keybase = isctx ? t0 : CTXL + t0;
        const bool dopool = !(isctx && last);
        u32x4 kr[2][2], vr[4], ur[5];
#pragma unroll
        for (int i = 0; i < 2; ++i) { const bf16* p = ZQ + (size_t)(row0 + tk0 + 32 * i) * ZQW + kcol; kr[i][0] = *(const u32x4*)p; kr[i][1] = *(const u32x4*)(p + 8); }
#pragma unroll
        for (int i = 0; i < 4; ++i) { const int idx = tid + NTHR * i; const int tok = idx >> 5, c8 = (idx & 31) * 8; const int zc = c8 < 128 ? ZC_VA + c8 : ZC_VC + (c8 - 128);
            vr[i] = *(const u32x4*)(ZQ + (size_t)(row0 + tok) * ZQW + zc); }
        if (dopool) {
#pragma unroll
            for (int i = 0; i < 5; ++i) { const int idx = tid + NTHR * i; const int tr = idx >> 5, c8 = (idx & 31) * 8; const int tl = t0 - 8 + tr;
                ur[i] = (u32x4){0u, 0u, 0u, 0u}; if (tl >= 0 && tl < nseq) ur[i] = *(const u32x4*)(ZQ + (size_t)(seqrow0 + tl) * ZQW + ZC_U + c8); } }
#pragma unroll
        for (int i = 0; i < 4; ++i) { const int idx = tid + NTHR * i; const int tok = idx >> 5, c8 = (idx & 31) * 8; *(LAS u32x4*)(Vs + tok * 264 + c8) = vr[i]; }
        if (dopool) {
#pragma unroll
            for (int i = 0; i < 5; ++i) { const int idx = tid + NTHR * i; const int tr = idx >> 5, c8 = (idx & 31) * 8; *(LAS u32x4*)(Us + tr * 264 + c8) = ur[i]; } }
#pragma unroll
        for (int i = 0; i < 2; ++i) {
            const int tt = tk0 + 32 * i;
            const u32x4 ua = kr[i][0], ub = kr[i][1];
            float v[16];
            v[0] = bf_lo(ua.x); v[1] = bf_hi(ua.x); v[2] = bf_lo(ua.y); v[3] = bf_hi(ua.y); v[4] = bf_lo(ua.z); v[5] = bf_hi(ua.z); v[6] = bf_lo(ua.w); v[7] = bf_hi(ua.w);
            v[8] = bf_lo(ub.x); v[9] = bf_hi(ub.x); v[10] = bf_lo(ub.y); v[11] = bf_hi(ub.y); v[12] = bf_lo(ub.z); v[13] = bf_hi(ub.z); v[14] = bf_lo(ub.w); v[15] = bf_hi(ub.w);
            float ss = 0.f;
#pragma unroll
            for (int j = 0; j < 16; ++j) ss += v[j] * v[j];
            ss += __shfl_xor(ss, 1); ss += __shfl_xor(ss, 2);
            const float rstd = rsqrtf(ss * (1.0f / 64.0f) + EPS);
#pragma unroll
            for (int j = 0; j < 16; ++j) v[j] = v[j] * rstd * gq[j >> 2][j & 3];
            if (!isctx) {
                const int t = t0 + tt;
                const f32x4 c0 = *(const f32x4*)(cosT + t * 32 + qd * 8), c1 = *(const f32x4*)(cosT + t * 32 + qd * 8 + 4);
                const f32x4 s0 = *(const f32x4*)(sinT + t * 32 + qd * 8), s1 = *(const f32x4*)(sinT + t * 32 + qd * 8 + 4);
#pragma unroll
                for (int pi = 0; pi < 8; ++pi) { const float cs = pi < 4 ? c0[pi & 3] : c1[pi & 3], sn = pi < 4 ? s0[pi & 3] : s1[pi & 3];
                    const float x0 = v[2 * pi], x1 = v[2 * pi + 1]; v[2 * pi] = x0 * cs - x1 * sn; v[2 * pi + 1] = x0 * sn + x1 * cs; }
            }
            u32x4 oa, ob;
            oa.x = cvt_pk_bf16(v[0], v[1]); oa.y = cvt_pk_bf16(v[2], v[3]); oa.z = cvt_pk_bf16(v[4], v[5]); oa.w = cvt_pk_bf16(v[6], v[7]);
            ob.x = cvt_pk_bf16(v[8], v[9]); ob.y = cvt_pk_bf16(v[10], v[11]); ob.z = cvt_pk_bf16(v[12], v[13]); ob.w = cvt_pk_bf16(v[14], v[15]);
            bf16* kp = KB + ((size_t)((kbr * NB + b) * 2 + khk) * NKEY + keybase + tt) * 64 + qd * 16; *(u32x4*)kp = oa; *(u32x4*)(kp + 8) = ob;
        }
        __syncthreads();
#pragma unroll
        for (int ii = 0; ii < 4; ++ii) { const int i = tid + NTHR * ii; const int cc = i >> 3, pc = i & 7; const int mat = cc >> 6, d = cc & 63; const int br = mat >> 1, hk = mat & 1;
            unsigned short e[8];
#pragma unroll
            for (int j = 0; j < 8; ++j) { const int p = 8 * pc + j, q = p & 15; const int key = (p & ~15) + (q & 3) + 8 * ((q >> 2) & 1) + 4 * (q >> 3); e[j] = Vs[key * 264 + cc]; }
            u32x4 o; o.x = e[0] | ((unsigned)e[1] << 16); o.y = e[2] | ((unsigned)e[3] << 16); o.z = e[4] | ((unsigned)e[5] << 16); o.w = e[6] | ((unsigned)e[7] << 16);
            *(u32x4*)(VT + ((size_t)((br * NB + b) * 2 + hk) * 64 + d) * NKEY + keybase + 8 * pc) = o; }
        if (dopool) {
#pragma unroll
            for (int ii = 0; ii < 4; ++ii) { const int i = tid + NTHR * ii; const int tok = i >> 5, c8 = (i & 31) * 8; const int gi = c8 >> 6; const int hw = 1 << gi;
                const int tl = t0 + tok; const int lo = max(tl - hw, 0), hi = min(tl + hw, nseq);
                float s[8];
#pragma unroll
                for (int j = 0; j < 8; ++j) s[j] = 0.f;
                for (int tq = lo; tq < hi; ++tq) { const u32x4 v = *(const LAS u32x4*)(Us + (tq - t0 + 8) * 264 + c8);
                    s[0] += bf_lo(v.x); s[1] += bf_hi(v.x); s[2] += bf_lo(v.y); s[3] += bf_hi(v.y); s[4] += bf_lo(v.z); s[5] += bf_hi(v.z); s[6] += bf_lo(v.w); s[7] += bf_hi(v.w); }
                const float ic = 1.0f / (float)(hi - lo);
                const u32x4 uu = *(const LAS u32x4*)(Us + (tok + 8) * 264 + c8);
                u32x4 o;
                o.x = cvt_pk_bf16(s[0] * ic - bf_lo(uu.x), s[1] * ic - bf_hi(uu.x)); o.y = cvt_pk_bf16(s[2] * ic - bf_lo(uu.y), s[3] * ic - bf_hi(uu.y));
                o.z = cvt_pk_bf16(s[4] * ic - bf_lo(uu.z), s[5] * ic - bf_hi(uu.z)); o.w = cvt_pk_bf16(s[6] * ic - bf_lo(uu.w), s[7] * ic - bf_hi(uu.w));
                *(u32x4*)(OCAT + blk_off(row0 + tok, 384 + c8, 1024)) = o; } }
        __syncthreads();
    }
}

__device__ __forceinline__ void attn_load_q(const bf16* qrow, const float* qnw, const float* cosT, int t, bool rope, int h, bf16x8 (&qf)[4]) {
    u32x4 qr[4];
#pragma unroll
    for (int ds = 0; ds < 4; ++ds) qr[ds] = *(const u32x4*)(qrow + ds * 16);
    float v[32]; float ss = 0.f;
#pragma unroll
    for (int ds = 0; ds < 4; ++ds) { v[8 * ds + 0] = bf_lo(qr[ds].x); v[8 * ds + 1] = bf_hi(qr[ds].x); v[8 * ds + 2] = bf_lo(qr[ds].y); v[8 * ds + 3] = bf_hi(qr[ds].y);
        v[8 * ds + 4] = bf_lo(qr[ds].z); v[8 * ds + 5] = bf_hi(qr[ds].z); v[8 * ds + 6] = bf_lo(qr[ds].w); v[8 * ds + 7] = bf_hi(qr[ds].w); }
#pragma unroll
    for (int j = 0; j < 32; ++j) ss += v[j] * v[j];
    ss += __shfl_xor(ss, 32);
    const float rstd = rsqrtf(ss * (1.0f / 64.0f) + EPS);
#pragma unroll
    for (int ds = 0; ds < 4; ++ds) { const f32x4 g0 = *(const f32x4*)(qnw + ds * 16 + h * 8), g1 = *(const f32x4*)(qnw + ds * 16 + h * 8 + 4);
#pragma unroll
        for (int j = 0; j < 4; ++j) { v[8 * ds + j] = v[8 * ds + j] * rstd * g0[j]; v[8 * ds + 4 + j] = v[8 * ds + 4 + j] * rstd * g1[j]; } }
    if (rope) {
#pragma unroll
        for (int ds = 0; ds < 4; ++ds) { const f32x4 cs = *(const f32x4*)(cosT + t * 32 + 8 * ds + 4 * h), sn = *(const f32x4*)(cosT + 2048 * 32 + t * 32 + 8 * ds + 4 * h);
#pragma unroll
            for (int jp = 0; jp < 4; ++jp) { const float x0 = v[8 * ds + 2 * jp], x1 = v[8 * ds + 2 * jp + 1]; v[8 * ds + 2 * jp] = x0 * cs[jp] - x1 * sn[jp]; v[8 * ds + 2 * jp + 1] = x0 * sn[jp] + x1 * cs[jp]; } } }
#pragma unroll
    for (int ds = 0; ds < 4; ++ds) { u32x4 w; w.x = cvt_pk_bf16(v[8 * ds + 0] * QSCALE, v[8 * ds + 1] * QSCALE); w.y = cvt_pk_bf16(v[8 * ds + 2] * QSCALE, v[8 * ds + 3] * QSCALE);
        w.z = cvt_pk_bf16(v[8 * ds + 4] * QSCALE, v[8 * ds + 5] * QSCALE); w.w = cvt_pk_bf16(v[8 * ds + 6] * QSCALE, v[8 * ds + 7] * QSCALE); qf[ds] = __builtin_bit_cast(bf16x8, w); }
}
__device__ __forceinline__ void attn_unit(LAS unsigned char* lds, const bf16* Qp, int ldq, const bf16* Kp, const bf16* Vtp, bf16* Op, int ldo,
                                          int lat_t0, int lat_t1, bool band, int q0, float sink_l2, bool use_sink, const float* qnw, float mbound, const float* cosT, int qpos0, int nact, int tid, int wave, int lane) {
    const int c = lane & 31, h = lane >> 5;
    const bool active = wave < nact;
    u32x4 kreg, vreg;
    const int skey = tid >> 3, sch8 = (tid & 7) * 8;
    const unsigned kvoff = (unsigned)(skey * 64 + sch8) * 2u, vvoff = (unsigned)(skey * NKEY + sch8) * 2u;
    const int lsoff = skey * 72 + sch8;
#define ATT_KB(it_) ((it_) < 4 ? (it_) * 64 : CTXL + (lat_t0 + (it_) - 4) * 64)
#define ATT_LOAD(kr, vr, kb_) do { kr = *(const u32x4*)((const char*)(Kp + (size_t)(kb_) * 64) + kvoff); vr = *(const u32x4*)((const char*)(Vtp + (kb_)) + vvoff); } while (0)
    ATT_LOAD(kreg, vreg, 0);
    bf16x8 qfa[4], qfb[4];
    {   const int r0 = active ? wave * 64 + c : c;
        attn_load_q(Qp + (size_t)r0 * ldq + h * 8, qnw, cosT, qpos0 + r0, qpos0 >= 0, h, qfa);
        attn_load_q(Qp + (size_t)(r0 + 32) * ldq + h * 8, qnw, cosT, qpos0 + r0 + 32, qpos0 >= 0, h, qfb); }
    f32x16 oa0, oa1, ob0, ob1;
#pragma unroll
    for (int i = 0; i < 16; ++i) { oa0[i] = 0.f; oa1[i] = 0.f; ob0[i] = 0.f; ob1[i] = 0.f; }
    float M = mbound;
    if (use_sink) M = fmaxf(M, sink_l2);
    float la = (use_sink && h == 0) ? fast_exp2(sink_l2 - M) : 0.0f, lb = la;
    const float negM = -M;
    const int ntiles = 4 + (lat_t1 - lat_t0);
    constexpr int KSZ = 64 * 72, BUFSZ = 2 * KSZ;
    LAS bf16* Ls = (LAS bf16*)lds;
#define ATT_PK(dst, src, o_) do { u32x4 w_; w_.x = cvt_pk_bf16(src[o_ + 0], src[o_ + 1]); w_.y = cvt_pk_bf16(src[o_ + 2], src[o_ + 3]); w_.z = cvt_pk_bf16(src[o_ + 4], src[o_ + 5]); w_.w = cvt_pk_bf16(src[o_ + 6], src[o_ + 7]); dst = __builtin_bit_cast(bf16x8, w_); } while (0)
#define ATT_PVJ(j, sa_, sb_, o_) do { bf16x8 pa_, pb_; ATT_PK(pa_, sa_, o_); ATT_PK(pb_, sb_, o_); \
                oa0 = __builtin_amdgcn_mfma_f32_32x32x16_bf16(vf[2 * (j)], pa_, oa0, 0, 0, 0); oa1 = __builtin_amdgcn_mfma_f32_32x32x16_bf16(vf[2 * (j) + 1], pa_, oa1, 0, 0, 0); \
                ob0 = __builtin_amdgcn_mfma_f32_32x32x16_bf16(vf[2 * (j)], pb_, ob0, 0, 0, 0); ob1 = __builtin_amdgcn_mfma_f32_32x32x16_bf16(vf[2 * (j) + 1], pb_, ob1, 0, 0, 0); } while (0)
    auto tile_step = [&](int it, u32x4& KR, u32x4& VR) __attribute__((always_inline)) {
        LAS bf16* Ks = Ls + (it & 1) * BUFSZ; LAS bf16* Vs = Ks + KSZ;
        __syncthreads();
        if (it + 1 < ntiles) { LAS bf16* Kn = Ls + ((it + 1) & 1) * BUFSZ; *(LAS u32x4*)(Kn + lsoff) = KR; *(LAS u32x4*)(Kn + KSZ + lsoff) = VR;
            if (it + 2 < ntiles) ATT_LOAD(KR, VR, ATT_KB(it + 2)); }
        bool need = active, domask = false;
        if (band && it >= 4) { const int kp0 = (lat_t0 + it - 4) * 64, qa = q0 + wave * 64;
            need = need && (kp0 <= qa + 63 + 128) && (kp0 + 63 >= qa - 128);
            domask = !((kp0 >= qa + 63 - 128) && (kp0 + 63 <= qa + 128)); }
        if (need) {
            const LAS bf16* kt = Ks + c * 72 + h * 8;
            const LAS bf16* vt = Vs + c * 72 + h * 8;
            bf16x8 kf[8];
#pragma unroll
            for (int ds = 0; ds < 2; ++ds) { kf[2 * ds] = *(const LAS bf16x8*)(kt + ds * 16); kf[2 * ds + 1] = *(const LAS bf16x8*)(kt + 32 * 72 + ds * 16); }
            __builtin_amdgcn_sched_barrier(0);
            f32x16 sa0, sa1, sb0, sb1;
            f32x16 cinit; { float nm_ = negM; asm volatile("" : "+v"(nm_));
#pragma unroll
              for (int i = 0; i < 16; ++i) cinit[i] = nm_; }
            sa0 = __builtin_amdgcn_mfma_f32_32x32x16_bf16(kf[0], qfa[0], cinit, 0, 0, 0); sa1 = __builtin_amdgcn_mfma_f32_32x32x16_bf16(kf[1], qfa[0], cinit, 0, 0, 0);
            sb0 = __builtin_amdgcn_mfma_f32_32x32x16_bf16(kf[0], qfb[0], cinit, 0, 0, 0); sb1 = __builtin_amdgcn_mfma_f32_32x32x16_bf16(kf[1], qfb[0], cinit, 0, 0, 0);
#pragma unroll
            for (int ds = 2; ds < 4; ++ds) { kf[2 * ds] = *(const LAS bf16x8*)(kt + ds * 16); kf[2 * ds + 1] = *(const LAS bf16x8*)(kt + 32 * 72 + ds * 16); }
#pragma unroll
            for (int ds = 1; ds < 4; ++ds) {
                sa0 = __builtin_amdgcn_mfma_f32_32x32x16_bf16(kf[2 * ds], qfa[ds], sa0, 0, 0, 0); sa1 = __builtin_amdgcn_mfma_f32_32x32x16_bf16(kf[2 * ds + 1], qfa[ds], sa1, 0, 0, 0);
                sb0 = __builtin_amdgcn_mfma_f32_32x32x16_bf16(kf[2 * ds], qfb[ds], sb0, 0, 0, 0); sb1 = __builtin_amdgcn_mfma_f32_32x32x16_bf16(kf[2 * ds + 1], qfb[ds], sb1, 0, 0, 0); }
            __builtin_amdgcn_sched_barrier(0);
            if (domask) { const int kp = (lat_t0 + it - 4) * 64 + 4 * h - (q0 + wave * 64 + c) + 128;
#pragma unroll
                for (int i = 0; i < 16; ++i) { const unsigned d0 = (unsigned)(kp + (i & 3) + 8 * (i >> 2)), d1 = d0 + 32u, e0 = d0 - 32u, e1 = d0;
                    if (d0 > 256u) sa0[i] = -1e30f;
                    if (d1 > 256u) sa1[i] = -1e30f;
                    if (e0 > 256u) sb0[i] = -1e30f;
                    if (e1 > 256u) sb1[i] = -1e30f; } }
            float pa0 = 0.f, pa1 = 0.f, pb0 = 0.f, pb1 = 0.f;
#pragma unroll
            for (int i = 0; i < 16; ++i) { sa0[i] = fast_exp2(sa0[i]); sa1[i] = fast_exp2(sa1[i]); sb0[i] = fast_exp2(sb0[i]); sb1[i] = fast_exp2(sb1[i]); pa0 += sa0[i]; pa1 += sa1[i]; pb0 += sb0[i]; pb1 += sb1[i]; }
            la += pa0 + pa1; lb += pb0 + pb1;
            __builtin_amdgcn_sched_barrier(0);
            bf16x8 vf[8];
#pragma unroll
            for (int j = 0; j < 4; ++j) { vf[2 * j] = *(const LAS bf16x8*)(vt + j * 16); vf[2 * j + 1] = *(const LAS bf16x8*)(vt + 32 * 72 + j * 16); }
            ATT_PVJ(0, sa0, sb0, 0); ATT_PVJ(1, sa0, sb0, 8); ATT_PVJ(2, sa1, sb1, 0); ATT_PVJ(3, sa1, sb1, 8);
        }
    };
    *(LAS u32x4*)(Ls + lsoff) = kreg; *(LAS u32x4*)(Ls + KSZ + lsoff) = vreg;
    ATT_LOAD(kreg, vreg, ATT_KB(1));
    for (int it = 0; it < ntiles; ++it) tile_step(it, kreg, vreg);
#undef ATT_PVJ
#undef ATT_PK
#undef ATT_KB
#undef ATT_LOAD
    const float lta = la + __shfl_xor(la, 32), ltb = lb + __shfl_xor(lb, 32);
    const float inva = 1.0f / lta, invb = 1.0f / ltb;
    __syncthreads();
    if (active) {
        LAS bf16* osw = (LAS bf16*)(lds + 36864 + wave * 9216);
#pragma unroll
        for (int g4 = 0; g4 < 4; ++g4) {
            u32x2 w0, w1;
            w0.x = cvt_pk_bf16(oa0[4 * g4] * inva, oa0[4 * g4 + 1] * inva); w0.y = cvt_pk_bf16(oa0[4 * g4 + 2] * inva, oa0[4 * g4 + 3] * inva);
            w1.x = cvt_pk_bf16(oa1[4 * g4] * inva, oa1[4 * g4 + 1] * inva); w1.y = cvt_pk_bf16(oa1[4 * g4 + 2] * inva, oa1[4 * g4 + 3] * inva);
            *(LAS u32x2*)(osw + c * 72 + 4 * h + 8 * g4) = w0; *(LAS u32x2*)(osw + c * 72 + 4 * h + 32 + 8 * g4) = w1;
            w0.x = cvt_pk_bf16(ob0[4 * g4] * invb, ob0[4 * g4 + 1] * invb); w0.y = cvt_pk_bf16(ob0[4 * g4 + 2] * invb, ob0[4 * g4 + 3] * invb);
            w1.x = cvt_pk_bf16(ob1[4 * g4] * invb, ob1[4 * g4 + 1] * invb); w1.y = cvt_pk_bf16(ob1[4 * g4 + 2] * invb, ob1[4 * g4 + 3] * invb);
            *(LAS u32x2*)(osw + (32 + c) * 72 + 4 * h + 8 * g4) = w0; *(LAS u32x2*)(osw + (32 + c) * 72 + 4 * h + 32 + 8 * g4) = w1;
        }
        asm volatile("s_waitcnt lgkmcnt(0)" ::: "memory");
        const int wrow0 = wave * 64;
        char* ob = (char*)(Op + (size_t)(wrow0 >> 8) * 16 * 16384 + (size_t)(wrow0 & 255) * 64);
        int ln_ = lane; asm volatile("" : "+v"(ln_));
        const unsigned ovoff = (unsigned)((ln_ >> 3) * 64 + (ln_ & 7) * 8) * 2u;
#pragma unroll
        for (int j = 0; j < 8; ++j) { const int row = (ln_ >> 3) + 8 * j, ch = ln_ & 7;
            const u32x4 v = *(const LAS u32x4*)(osw + row * 72 + ch * 8);
            *(u32x4*)(ob + ovoff + (unsigned)(j * 8 * 64 * 2)) = v; }
        asm volatile("s_waitcnt lgkmcnt(0)" ::: "memory");
    }
}

__device__ __forceinline__ void phase_attn(const Args& a, int layer, LAS unsigned char* lds, int tid, int wave, int lane, int vcu, int G) {
    unsigned char* ws = a.ws;
    const bf16* ZQ = (const bf16*)(ws + WS_ZQ); bf16* OCAT = (bf16*)(ws + WS_B1); const bf16* KB = (const bf16*)(ws + WS_K); const bf16* VT = (const bf16*)(ws + WS_VT);
    const float* sink = a.in[13] + layer * 6; const float* cosT = (const float*)(ws + WS_ROPE);
    const float* qn_a = a.in[9] + layer * 64; const float* qn_c = a.in[11] + layer * 64; const float* kn_a = a.in[10] + layer * 64; const float* kn_c = a.in[12] + layer * 64;
    const int nunits = layer == 0 ? 1536 + 384 : 1536;
    float mb_a, mb_c;
    {   float ga = fabsf(qn_a[lane]), ka = fabsf(kn_a[lane]), gc = fabsf(qn_c[lane]), kc = fabsf(kn_c[lane]);
#pragma unroll
        for (int o = 1; o < 64; o <<= 1) { ga = fmaxf(ga, __shfl_xor(ga, o)); ka = fmaxf(ka, __shfl_xor(ka, o)); gc = fmaxf(gc, __shfl_xor(gc, o)); kc = fmaxf(kc, __shfl_xor(kc, o)); }
        mb_a = __int_as_float(__builtin_amdgcn_readfirstlane(__float_as_int(64.0f * 1.03f * QSCALE * ga * ka)));
        mb_c = __int_as_float(__builtin_amdgcn_readfirstlane(__float_as_int(64.0f * 1.03f * QSCALE * gc * kc))); }
    for (int p = vcu; p < nunits; p += G) {
        int br, b, head, row0, lat0 = 0, lat1 = 0, q0 = 0, qpos0 = -1, nact = 8; bool band = false, use_sink = false;
        if (p < 1536) {
            br = p >= 768 ? 1 : 0; const int pp = p - br * 768;
            const int qb = pp & 3, g = (pp >> 2) % 3, bhk = pp / 12; b = bhk >> 1; head = (bhk & 1) * 3 + g;
            q0 = qb * 512; row0 = b * SEQ + q0; qpos0 = q0;
            if (br == 0) { lat0 = 0; lat1 = 32; }
            else { lat0 = max(q0 - 128, 0) / 64; lat1 = min(q0 + 512 + 128, SEQ) / 64; band = true; use_sink = true; }
        } else {
            const int pp = p - 1536; br = pp >= 192 ? 1 : 0; const int q = pp - br * 192; b = q / 6; head = q % 6;
            row0 = TL + b * CTXL; use_sink = br != 0; nact = 4;
        }
        const int hk = head / 3;
        const bf16* Qp = ZQ + (size_t)row0 * ZQW + (br ? ZC_QC : ZC_QA) + head * 64;
        const size_t kvi = (size_t)((br * NB + b) * 2 + hk);
        bf16* Op = OCAT + blk_off(row0, (br ? 640 : 0) + head * 64, 1024);
        attn_unit(lds, Qp, ZQW, KB + kvi * NKEY * 64, VT + kvi * 64 * NKEY, Op, 1024, lat0, lat1, band, q0, use_sink ? sink[head] * LOG2E : 0.f, use_sink, br ? qn_c : qn_a, br ? mb_c : mb_a, cosT, qpos0, nact, tid, wave, lane);
    }
}

#define XB_TMO      128
#define XB_XCNT(j)  (256  + 64 * (j))
#define XB_XSUB(j)  (1280 + 64 * (j))
#define XB_XGEN(j)  (2304 + 64 * (j))
#define XB_TOP      3328
#define XB_TOPGEN   3392
#define XCD_BAR_WORDS 3456
#define XB_SPIN_CAP (1u << 18)
__device__ __forceinline__ unsigned xb_ld(unsigned* p)              { return __hip_atomic_load(p, __ATOMIC_RELAXED, __HIP_MEMORY_SCOPE_AGENT); }
__device__ __forceinline__ unsigned xb_add(unsigned* p, unsigned v) { return __hip_atomic_fetch_add(p, v, __ATOMIC_RELAXED, __HIP_MEMORY_SCOPE_AGENT); }
__device__ __forceinline__ unsigned xb_xcc_id() { return (unsigned)__builtin_amdgcn_s_getreg((3 << 11) | 20) & 0xFu; }
#define XB_SPIN(cond, bar) do { unsigned _sp = 0; while (cond) { __builtin_amdgcn_s_sleep(1); \
    if ((++_sp & 255u) == 0u) { if (xb_ld(&(bar)[XB_TMO])) break; if (_sp > XB_SPIN_CAP) { atomicAdd(&(bar)[XB_TMO], 1u); break; } } } } while (0)
struct XcdBarrier { unsigned* bar; unsigned x; volatile LAS unsigned* st; };
__device__ __forceinline__ XcdBarrier xcd_barrier_post(unsigned* bar, volatile LAS unsigned* st) {
    XcdBarrier b; b.bar = bar; b.x = xb_xcc_id(); b.st = st;
    if (threadIdx.x == 0) (void)xb_add(&bar[XB_XCNT(b.x)], 1u);
    return b;
}
__device__ __forceinline__ void xcd_barrier_complete(unsigned* bar, unsigned x, unsigned& nloc, unsigned& nx) {
    const unsigned G = gridDim.x * gridDim.y * gridDim.z;
    unsigned sum, cnt, mine, sp = 0u;
    for (;;) {
        sum = 0u; cnt = 0u; mine = 0u;
#pragma unroll
        for (unsigned j = 0; j < 16; ++j) { const unsigned c = xb_ld(&bar[XB_XCNT(j)]); sum += c; cnt += (c > 0u) ? 1u : 0u; mine = (j == x) ? c : mine; }
        if (sum == G) break;
        __builtin_amdgcn_s_sleep(1);
        if ((++sp & 255u) == 0u) { if (xb_ld(&bar[XB_TMO])) break; if (sp > XB_SPIN_CAP) { atomicAdd(&bar[XB_TMO], 1u); break; } }
    }
    nloc = mine > 0u ? mine : 1u; nx = cnt > 0u ? cnt : 1u;
}
__device__ __forceinline__ void xcd_barrier(const XcdBarrier& b) {
    asm volatile("s_waitcnt vmcnt(0)" ::: "memory");
    __syncthreads();
    if (threadIdx.x == 0) {
        unsigned* bar = b.bar;
        __builtin_amdgcn_s_waitcnt(0);
        unsigned nloc = b.st[0], nx = b.st[1];
        if (nloc == 0u) { xcd_barrier_complete(bar, b.x, nloc, nx); b.st[0] = nloc; b.st[1] = nx; }
        const unsigned old = xb_add(&bar[XB_XSUB(b.x)], 1u);
        const unsigned gen = old / nloc;
        if (old + 1u == (gen + 1u) * nloc) {
            __builtin_amdgcn_fence(__ATOMIC_RELEASE, "agent");
            asm volatile("s_waitcnt vmcnt(0)" ::: "memory");
            const unsigned og = xb_add(&bar[XB_TOP], 1u);
            const unsigned tg = og / nx;
            if (og + 1u == (tg + 1u) * nx) xb_add(&bar[XB_TOPGEN], 1u);
            else XB_SPIN(xb_ld(&bar[XB_TOPGEN]) == tg, bar);
            __builtin_amdgcn_fence(__ATOMIC_ACQUIRE, "agent");
            xb_add(&bar[XB_XGEN(b.x)], 1u);
            asm volatile("s_waitcnt vmcnt(0)" ::: "memory");
        } else {
            XB_SPIN(xb_ld(&bar[XB_XGEN(b.x)]) == gen, bar);
            __builtin_amdgcn_fence(__ATOMIC_ACQUIRE, "agent");
            asm volatile("s_waitcnt vmcnt(0)" ::: "memory");
        }
    }
    __syncthreads();
}

__global__ void __launch_bounds__(NTHR, 2) fwd_kernel(Args a) {
    extern __shared__ __attribute__((aligned(16))) unsigned char lds_raw[];
    LAS unsigned char* lds = (LAS unsigned char*)lds_raw;
    cg::grid_group grid = cg::this_grid();
    int tid = threadIdx.x, lane = tid & 63, wave = __builtin_amdgcn_readfirstlane(tid >> 6);
#define FRESH() do { tid = threadIdx.x; asm volatile("" : "+v"(tid)); lane = tid & 63; wave = __builtin_amdgcn_readfirstlane(tid >> 6); } while (0)
    const int G = gridDim.x, bx = blockIdx.x;
    const int vcu = (G % 8 == 0) ? (bx % 8) * (G / 8) + bx / 8 : bx;
    const int NGW = G * NWAVES;
    unsigned char* ws = a.ws;
    const int lo = a.ph_lo, hi = a.ph_hi;
    volatile LAS unsigned* bst = (volatile LAS unsigned*)(lds + LDS_BYTES - 16);
    if (tid < 4) bst[tid] = 0u;
    __syncthreads();
    XcdBarrier bar; bar.bar = (unsigned*)ws; bar.x = 0; bar.st = bst;
    if (hi - lo > 1) bar = xcd_barrier_post((unsigned*)ws, bst);
#ifndef PHMASK
#define PHMASK 0x7ffff
#endif
#define IN(k) (((PHMASK >> ((k) > 9 ? (k) - 9 : (k))) & 1) && lo <= (k) && (k) < hi)
#ifndef DUPMASK
#define DUPMASK 0
#endif
#define NREP(k) (((DUPMASK >> ((k) > 9 ? (k) - 9 : (k))) & 1) ? 2 : 1)
#define SEAM(k) do { if (hi - lo > 1) { if (hi == 0x7fffffff) grid.sync();   xcd_barrier(bar); } } while (0)

    float* mod = (float*)(ws + WS_MOD);
    float* XC = (float*)(ws + WS_XC);
    bf16* B1 = (bf16*)(ws + WS_B1); bf16* ZQ = (bf16*)(ws + WS_ZQ); bf16* Gt = (bf16*)(ws + WS_G); bf16* Y = ZQ; bf16* A1 = ZQ;

    if (IN(0)) for (int rep = 0; rep < NREP(0); ++rep) { FRESH(); phase_prologue(a, lds, tid, wave, lane, G); }
    SEAM(0);
    const float* BIAS1 = (const float*)(ws + WS_BIAS1); const float* BIAS2 = (const float*)(ws + WS_BIAS2);
    const float* AVb = (const float*)(ws + WS_AV); float* RSS = (float*)(ws + WS_RSS);
#pragma unroll 1
    for (int l = 0; l < 2; ++l) {
        const int P = 1 + 9 * l;
        const bool last = l == 1;
        const float* modl = mod + (size_t)l * 33 * 6144;
        unsigned char* wl = ws + WS_W + l * WL_SIZE;
        const float* xlat = l == 0 ? a.in[0] : a.out; const float* xctx = l == 0 ? a.in[2] : XC;
        const int nMall = last ? 256 : 288;
        if (l == 0) {
            if (IN(P + 0)) {
                if (bx < 50) { const int job = bx < 18 ? 0 : (bx < 34 ? 1 : 2); const int nN = job == 0 ? 18 : 16; const int c = job == 0 ? bx : (job == 1 ? bx - 18 : bx - 34);
                    const bf16* Ash = (const bf16*)(ws + WS_SH) + (size_t)job * 256 * 1024;
                    const bf16* Bw = job == 0 ? (const bf16*)(ws + WS_W + 1 * WL_SIZE + WL_IN) : (const bf16*)(ws + WS_W + (job - 1) * WL_SIZE + WL_W1);
                    float* outp = job == 0 ? (float*)(ws + WS_BIAS1) : (float*)(ws + WS_BIAS2) + (size_t)(job - 1) * 33 * FF;
                    pg8::Order S; S.init(1, nN, 0, 0, 1, 16, nN, c); pg8::EpiBias E{outp, job == 0 ? INW : FF};
                    pg8::gemm_phase(lds, Ash, 1024, Bw, 1024, S, E); }
                FRESH(); phase_norm(xlat, xctx, a.in[6] + l * 1024, modl, 0, 1, B1, TT, vcu * NWAVES + wave, NGW, lane);
            }
            SEAM(P + 0);
        }
        if (IN(P + 1)) { pg8::Order S; S.init(256, 18, 32, last ? 2 : 18, 1, 16, G, bx); pg8::EpiInProj E{ZQ, Gt, RSS + (size_t)1 * TT, BIAS1, l};
            pg8::gemm_phase(lds, B1, 1024, (const bf16*)(wl + WL_IN), 1024, S, E); }
        SEAM(P + 1);
        if (IN(P + 2)) { FRESH(); phase_qkvpool(a, l, lds, tid, wave, lane, vcu, G); }
        SEAM(P + 2);
        if (IN(P + 3)) { FRESH(); phase_attn(a, l, lds, tid, wave, lane, vcu, G); }
        SEAM(P + 3);
        if (IN(P + 4)) { pg8::Order S; S.init(nMall, 4, 0, 0, 1, 16, G, bx); pg8::EpiMerge E{Gt, Y};
            pg8::gemm_phase(lds, B1, 1024, (const bf16*)(wl + WL_BR), 1024, S, E); }
        SEAM(P + 4);
        if (IN(P + 5)) { pg8::Order S; S.init(nMall, 4, 0, 0, 1, 16, G, bx);
            pg8::EpiResid E{xlat, xctx, a.out, XC, modl, 2, B1, AVb + (size_t)(l * 2 + 1) * 33 * 1024, RSS + (size_t)(l == 0 ? 0 : 2) * TT};
            pg8::gemm_phase(lds, Y, 1024, (const bf16*)(wl + WL_WO), 1024, S, E); }
        SEAM(P + 5);
        if (IN(P + 7)) { pg8::Order S; S.init(nMall, 16, 0, 0, 1, 16, G, bx); pg8::EpiMlp1 E{A1, RSS + (size_t)(l == 0 ? 0 : 2) * TT, BIAS2 + (size_t)l * 33 * FF};
            pg8::gemm_phase(lds, B1, 1024, (const bf16*)(wl + WL_W1), 1024, S, E); }
        SEAM(P + 7);
        if (IN(P + 8)) { pg8::Order S; S.init(nMall, 4, 0, 0, 1, 64, G, bx);
            pg8::EpiResid E{a.out, XC, a.out, XC, modl, 5, last ? (bf16*)nullptr : B1, AVb + (size_t)(1 * 2 + 0) * 33 * 1024, RSS + (size_t)1 * TT};
            pg8::gemm_phase(lds, A1, FF, (const bf16*)(wl + WL_W2), FF, S, E); }
        if (!last) SEAM(P + 8);
    }
#undef IN
#undef SEAM
}

extern "C" void kernel_launch(void* const* d_in, const int* in_sizes, int n_in, void* d_out, int out_size, void* d_ws, size_t ws_size, hipStream_t stream) {
    static int grid = 0;
    if (grid == 0) {
        if (n_in != 22 || ws_size < WS_END) { fprintf(stderr, "kernel_launch: unexpected n_in %d / ws_size %zu (need %zu)\n", n_in, ws_size, (size_t)WS_END); grid = -1; return; }
        int dev = 0, cus = 0, per_cu = 0;
        hipGetDevice(&dev);
        hipDeviceGetAttribute(&cus, hipDeviceAttributeMultiprocessorCount, dev);
        if (hipFuncSetAttribute((const void*)fwd_kernel, hipFuncAttributeMaxDynamicSharedMemorySize, LDS_BYTES) != hipSuccess) { fprintf(stderr, "kernel_launch: hipFuncSetAttribute failed\n"); grid = -1; return; }
        hipOccupancyMaxActiveBlocksPerMultiprocessor(&per_cu, (const void*)fwd_kernel, NTHR, LDS_BYTES);
        (void)hipGetLastError();
        if (per_cu < 1) per_cu = 1;
        grid = cus;
        fprintf(stderr, "kernel_launch: cus %d per_cu %d grid %d ws %zu\n", cus, per_cu, grid, ws_size);
    }
    if (grid < 0) return;
    Args a{};
    for (int i = 0; i < 22; ++i) a.in[i] = (const float*)d_in[i];
    a.out = (float*)d_out; a.ws = (unsigned char*)d_ws;
#if ONE_LAUNCH
    if (hipMemsetAsync(d_ws, 0, XCD_BAR_WORDS * 4, stream) != hipSuccess) { fprintf(stderr, "memset failed\n"); return; }
    a.ph_lo = 0; a.ph_hi = 19;
    void* args[] = {&a};
    hipError_t e = hipLaunchCooperativeKernel((const void*)fwd_kernel, dim3(grid), dim3(NTHR), args, LDS_BYTES, stream);
    if (e != hipSuccess) fprintf(stderr, "cooperative launch failed: %s (grid %d)\n", hipGetErrorString(e), grid);
#else
    for (int ph = 0; ph < 19; ++ph) { a.ph_lo = ph; a.ph_hi = ph + 1; hipLaunchKernelGGL(fwd_kernel, dim3(grid), dim3(NTHR), LDS_BYTES, stream, a); }
#endif
}
```
